# Optimizing an MI355X kernel written in HIP

```python
import math
import jax, jax.numpy as jnp
from jax import lax
import numpy as np

D_MODEL = 1024
BATCH = 4
SEQ = 4096
DEPTH = 4

MEM_LEN = 256
D_POOL = D_MODEL // 2
POOL_WINDOWS = (2, 4, 8, 16)
N_POOL_GROUPS = len(POOL_WINDOWS)
POOL_GROUP_DIM = D_POOL // N_POOL_GROUPS
D_SG = D_MODEL // 2
N_SG_HEADS = 4
SG_HEAD_DIM = D_SG // N_SG_HEADS
CHUNK = 128
D_CONV = D_MODEL
CONV_WIDTH = 3
N_XHEADS = 4
XHEAD_DIM = D_MODEL // N_XHEADS
N_GROUPS = 4
EXPERTS_PER_GROUP = 8
N_EXPERTS = N_GROUPS * EXPERTS_PER_GROUP
TOP_K_INNER = 2
D_EXPERT = 512
DISPATCH_BLOCK = 128
N_EVEN = (DEPTH + 1) // 2
N_ODD = DEPTH // 2
ALPHA = (2.0 * DEPTH) ** 0.25
BETA = (8.0 * DEPTH) ** -0.25
LN_EPS = 1e-5

kernel_name = "hybrid_pool_sgate_shortconv_hmoe_deepnorm"


def layer_norm(x, g, b):
    xf = x.astype(jnp.float32)
    mu = jnp.mean(xf, axis=-1, keepdims=True)
    var = jnp.mean(jnp.square(xf - mu), axis=-1, keepdims=True)
    y = (xf - mu) * lax.rsqrt(var + LN_EPS)
    return (y * g.astype(jnp.float32) + b.astype(jnp.float32)).astype(x.dtype)


def pool_mixer(a, w_pool, pool_scale):
    B, S, _ = a.shape
    a4 = a.astype(jnp.float32).reshape(B, S, N_POOL_GROUPS, POOL_GROUP_DIM)
    cs = jnp.cumsum(a4, axis=1)
    pos = jnp.arange(1, S + 1, dtype=jnp.float32)
    diffs = []
    for g, w in enumerate(POOL_WINDOWS):
        cs_g = cs[:, :, g]
        lagged = jnp.pad(cs_g, ((0, 0), (w, 0), (0, 0)))[:, :S]
        cnt = jnp.minimum(pos, float(w))[None, :, None]
        diffs.append((cs_g - lagged) / cnt - a4[:, :, g])
    d = jnp.stack(diffs, axis=2)
    y = jnp.einsum('bsgc,gcd->bsgd', d, w_pool.astype(jnp.float32))
    y = y.reshape(B, S, D_POOL) * pool_scale.astype(jnp.float32)
    return y.astype(a.dtype)


def spatial_gating(z, ln_v_g, ln_v_b, w_spatial, b_spatial):
    B, S, _ = z.shape
    u, v = z[..., :D_SG], z[..., D_SG:]
    v = layer_norm(v, ln_v_g, ln_v_b)
    vc = v.reshape(B, S // CHUNK, CHUNK, N_SG_HEADS, SG_HEAD_DIM)
    mask = jnp.tril(jnp.ones((CHUNK, CHUNK), dtype=w_spatial.dtype))
    ws = w_spatial * mask[None]
    sv = jnp.einsum('hij,bnjhc->bnihc', ws, vc) + b_spatial.T[:, :, None]
    return u * sv.reshape(B, S, D_SG)


def even_mixer(x, w_in, w_pool, pool_scale, ln_v_g, ln_v_b, w_spatial, b_spatial, w_out):
    h = x @ w_in
    a_out = pool_mixer(h[..., :D_POOL], w_pool, pool_scale)
    b_out = spatial_gating(jax.nn.gelu(h[..., D_POOL:]), ln_v_g, ln_v_b, w_spatial, b_spatial)
    return jnp.concatenate([a_out, b_out], axis=-1) @ w_out


def odd_mixer(x, w_in, conv_w, conv_b, w_out):
    S = x.shape[1]
    h = x @ w_in
    bg, cg, z = h[..., :D_CONV], h[..., D_CONV:2 * D_CONV], h[..., 2 * D_CONV:]
    zc = cg * z
    zp = jnp.pad(zc, ((0, 0), (CONV_WIDTH - 1, 0), (0, 0)))
    conv = conv_b + zp[:, 0:S] * conv_w[:, 0] + zp[:, 1:S + 1] * conv_w[:, 1] + zp[:, 2:S + 2] * conv_w[:, 2]
    return (bg * conv) @ w_out


def memory_cross_attn(x, mem, wq, wk, wv, wo):
    B, S, D = x.shape
    M = mem.shape[1]
    q = (x @ wq).reshape(B, S, N_XHEADS, XHEAD_DIM)
    k = (mem @ wk).reshape(B, M, N_XHEADS, XHEAD_DIM)
    v = (mem @ wv).reshape(B, M, N_XHEADS, XHEAD_DIM)
    s = jnp.einsum('bshd,bmhd->bhsm', q, k).astype(jnp.float32) / math.sqrt(XHEAD_DIM)
    p = jax.nn.softmax(s, axis=-1).astype(v.dtype)
    o = jnp.einsum('bhsm,bmhd->bshd', p, v).reshape(B, S, D)
    return o @ wo


def expert_dispatch(xf, expert_ids, gates, w1, w3, w2):
    N, D = xf.shape
    A = N * TOP_K_INNER
    e_flat = expert_ids.reshape(-1)
    g_flat = gates.reshape(-1)
    tok = jnp.arange(A, dtype=jnp.int32) // TOP_K_INNER
    order = jnp.argsort(e_flat)
    se, stok, sg = e_flat[order], tok[order], g_flat[order]
    counts = jnp.zeros((N_EXPERTS,), jnp.int32).at[e_flat].add(1)
    start = jnp.cumsum(counts) - counts
    pcounts = (counts + DISPATCH_BLOCK - 1) // DISPATCH_BLOCK * DISPATCH_BLOCK
    pend = jnp.cumsum(pcounts)
    pstart = pend - pcounts
    dest = pstart[se] + (jnp.arange(A, dtype=jnp.int32) - start[se])
    n_blocks = (A + N_EXPERTS * (DISPATCH_BLOCK - 1) + DISPATCH_BLOCK - 1) // DISPATCH_BLOCK
    P = n_blocks * DISPATCH_BLOCK
    buf_tok = jnp.full((P,), N, jnp.int32).at[dest].set(stok)
    buf_gate = jnp.zeros((P,), gates.dtype).at[dest].set(sg)
    block_e = jnp.minimum(
        jnp.searchsorted(pend, jnp.arange(n_blocks, dtype=jnp.int32) * DISPATCH_BLOCK, side='right'),
        N_EXPERTS - 1)
    xpad = jnp.concatenate([xf, jnp.zeros((1, D), xf.dtype)], axis=0)
    xb = xpad[buf_tok].reshape(n_blocks, DISPATCH_BLOCK, D)

    def expert_block(args):
        xblk, e = args
        hid = jax.nn.silu(xblk @ w1[e]) * (xblk @ w3[e])
        return hid @ w2[e]

    yb = lax.map(expert_block, (xb, block_e)).reshape(P, D) * buf_gate[:, None]
    return jnp.zeros((N + 1, D), yb.dtype).at[buf_tok].add(yb)[:N]


def hierarchical_moe(x, wr_g, br_g, wr_e, br_e, w1, w3, w2):
    B, S, D = x.shape
    xf = x.reshape(B * S, D)
    x32 = xf.astype(jnp.float32)
    logits_g = x32 @ wr_g.astype(jnp.float32) + br_g.astype(jnp.float32)
    p_g = jax.nn.softmax(logits_g, axis=-1)
    g_sel = jnp.argmax(logits_g, axis=-1).astype(jnp.int32)
    gate_g = jnp.take_along_axis(p_g, g_sel[:, None], axis=1)[:, 0]
    logits_all = jnp.einsum('nd,gde->nge', x32, wr_e.astype(jnp.float32)) + br_e.astype(jnp.float32)
    logits_e = jnp.take_along_axis(logits_all, g_sel[:, None, None], axis=1)[:, 0]
    top_v, top_i = lax.top_k(logits_e, TOP_K_INNER)
    w_inner = jax.nn.softmax(top_v, axis=-1)
    expert_ids = g_sel[:, None] * EXPERTS_PER_GROUP + top_i.astype(jnp.int32)
    gates = (gate_g[:, None] * w_inner).astype(x.dtype)
    y = expert_dispatch(xf, expert_ids, gates, w1, w3, w2)
    return y.reshape(B, S, D)


def setup_inputs(seed: int = 0) -> dict:
    key = jax.random.key(seed)
    ks = iter(jax.random.split(key, 40))
    f32 = jnp.float32
    D = D_MODEL

    def nrm(shape, scale):
        return jax.random.normal(next(ks), shape, f32) * scale

    d_in_even = D_POOL + 2 * D_SG
    return {
        "x": nrm((BATCH, SEQ, D), 1.0),
        "mem": nrm((BATCH, MEM_LEN, D), 1.0),
        "w_in_even": nrm((N_EVEN, D, d_in_even), D ** -0.5),
        "w_pool": nrm((N_EVEN, N_POOL_GROUPS, POOL_GROUP_DIM, POOL_GROUP_DIM), POOL_GROUP_DIM ** -0.5),
        "pool_scale": 1.0 + nrm((N_EVEN, D_POOL), 0.1),
        "ln_v_g": 1.0 + nrm((N_EVEN, D_SG), 0.02),
        "ln_v_b": nrm((N_EVEN, D_SG), 0.02),
        "w_spatial": nrm((N_EVEN, N_SG_HEADS, CHUNK, CHUNK), CHUNK ** -0.5),
        "b_spatial": 1.0 + nrm((N_EVEN, N_SG_HEADS, CHUNK), 0.1),
        "w_out_even": nrm((N_EVEN, D_POOL + D_SG, D), (D_POOL + D_SG) ** -0.5 * BETA),
        "w_in_odd": nrm((N_ODD, D, 3 * D_CONV), D ** -0.5),
        "conv_w": nrm((N_ODD, D_CONV, CONV_WIDTH), CONV_WIDTH ** -0.5),
        "conv_b": nrm((N_ODD, D_CONV), 0.02),
        "w_out_odd": nrm((N_ODD, D_CONV, D), D_CONV ** -0.5 * BETA),
        "wq_x": nrm((DEPTH, D, D), D ** -0.5),
        "wk_x": nrm((DEPTH, D, D), D ** -0.5),
        "wv_x": nrm((DEPTH, D, D), D ** -0.5 * BETA),
        "wo_x": nrm((DEPTH, D, D), D ** -0.5 * BETA),
        "ln_g": 1.0 + nrm((DEPTH, 3, D), 0.02),
        "ln_b": nrm((DEPTH, 3, D), 0.02),
        "wr_group": nrm((DEPTH, D, N_GROUPS), D ** -0.5),
        "br_group": nrm((DEPTH, N_GROUPS), 0.01),
        "wr_expert": nrm((DEPTH, N_GROUPS, D, EXPERTS_PER_GROUP), D ** -0.5),
        "br_expert": nrm((DEPTH, N_GROUPS, EXPERTS_PER_GROUP), 0.01),
        "w1": nrm((DEPTH, N_EXPERTS, D, D_EXPERT), D ** -0.5),
        "w3": nrm((DEPTH, N_EXPERTS, D, D_EXPERT), D ** -0.5),
        "w2": nrm((DEPTH, N_EXPERTS, D_EXPERT, D), D_EXPERT ** -0.5 * BETA),
    }


def reference(x, mem, w_in_even, w_pool, pool_scale, ln_v_g, ln_v_b, w_spatial, b_spatial,
              w_out_even, w_in_odd, conv_w, conv_b, w_out_odd, wq_x, wk_x, wv_x, wo_x,
              ln_g, ln_b, wr_group, br_group, wr_expert, br_expert, w1, w3, w2):
    for l in range(DEPTH):
        i = l // 2
        if l % 2 == 0:
            mix = even_mixer(x, w_in_even[i], w_pool[i], pool_scale[i], ln_v_g[i], ln_v_b[i],
                             w_spatial[i], b_spatial[i], w_out_even[i])
        else:
            mix = odd_mixer(x, w_in_odd[i], conv_w[i], conv_b[i], w_out_odd[i])
        x = layer_norm(ALPHA * x + mix, ln_g[l, 0], ln_b[l, 0])
        xa = memory_cross_attn(x, mem, wq_x[l], wk_x[l], wv_x[l], wo_x[l])
        x = layer_norm(ALPHA * x + xa, ln_g[l, 1], ln_b[l, 1])
        ff = hierarchical_moe(x, wr_group[l], br_group[l], wr_expert[l], br_expert[l],
                              w1[l], w3[l], w2[l])
        x = layer_norm(ALPHA * x + ff, ln_g[l, 2], ln_b[l, 2])
    return x
```

```cpp
#include <hip/hip_runtime.h>
#include <cstdio>
#include <cstdint>
#include <cstddef>

typedef unsigned short bf16;
__device__ __forceinline__ unsigned f2bf(float f) { unsigned u = __builtin_bit_cast(unsigned, f); return (u + 0x7fffu + ((u >> 16) & 1u)) >> 16; }
__device__ __forceinline__ float bf2f(bf16 b) { return __builtin_bit_cast(float, ((unsigned)b) << 16); }

constexpr int DM = 1024, BATCH = 4, SEQ = 4096, NTOK = BATCH * SEQ, DEPTH = 4, MEM = 256, NMEM = BATCH * MEM;
constexpr int DPOOL = 512, DSG = 512, NHSG = 4, CHUNK = 128, DIN_E = DPOOL + 2 * DSG, DIN_O = 3 * DM;
constexpr int NXH = 4, XHD = 256, NGRP = 4, EPG = 8, NEXP = 32, DEXP = 512;
constexpr float ALPHA = 1.6817928305074290f;
constexpr float LN_EPS = 1e-5f;
constexpr int LIST_CAP = NTOK;

constexpr size_t MiB = 1u << 20;
constexpr size_t WS_CTL = 0, CTL_BYTES = 1 * MiB;
constexpr size_t WS_X = 1 * MiB;
constexpr size_t WS_XB = WS_X + 64 * MiB;
constexpr size_t WS_Y = WS_XB + 32 * MiB;
constexpr size_t WS_CAT = WS_Y + 64 * MiB;
constexpr size_t WS_KV = WS_CAT + 32 * MiB;
constexpr size_t WS_MEMB = WS_KV + 16 * MiB;
constexpr size_t WS_LIST = WS_MEMB + 2 * MiB;
constexpr size_t WS_GATE = WS_LIST + 2 * MiB;
constexpr size_t WS_SCR = WS_GATE + 1 * MiB;
constexpr size_t WS_END = WS_SCR + 160 * MiB;
constexpr int CW_CNT = 1024;
constexpr int CW_OFF = 2048;

template <class P>
__global__ __launch_bounds__(256) void k_ngemm(P p) {
    __shared__ float As[16][132];
    __shared__ float Bs[16][132];
    const int z = blockIdx.z, m0 = blockIdx.y * 128, n0 = blockIdx.x * 128;
    const int rows = p.rows(z);
    if (m0 >= rows) return;
    const float* B = p.b(z); const int ldb = p.ldb(); const int K = p.K();
    const int tid = threadIdx.x, tx = tid & 15, ty = tid >> 4;
    float acc[8][8];
#pragma unroll
    for (int i = 0; i < 8; ++i)
#pragma unroll
        for (int j = 0; j < 8; ++j) acc[i][j] = 0.f;
    for (int k0 = 0; k0 < K; k0 += 16) {
#pragma unroll
        for (int i = 0; i < 8; ++i) { const int idx = tid + i * 256, r = idx >> 4, kk = idx & 15; As[kk][r] = (m0 + r < rows) ? p.a(z, m0 + r, k0 + kk) : 0.f; }
#pragma unroll
        for (int i = 0; i < 8; ++i) { const int idx = tid + i * 256, kk = idx >> 7, n = idx & 127; Bs[kk][n] = B[(size_t)(k0 + kk) * ldb + n0 + n]; }
        __syncthreads();
#pragma unroll
        for (int kk = 0; kk < 16; ++kk) {
            float a[8], b[8];
#pragma unroll
            for (int i = 0; i < 8; ++i) a[i] = As[kk][ty + 16 * i];
#pragma unroll
            for (int j = 0; j < 8; ++j) b[j] = Bs[kk][tx + 16 * j];
#pragma unroll
            for (int i = 0; i < 8; ++i)
#pragma unroll
                for (int j = 0; j < 8; ++j) acc[i][j] += a[i] * b[j];
        }
        __syncthreads();
    }
#pragma unroll
    for (int i = 0; i < 8; ++i) { const int m = m0 + ty + 16 * i; if (m < rows) {
#pragma unroll
        for (int j = 0; j < 8; ++j) p.store(z, m, n0 + tx + 16 * j, acc[i][j]); } }
}

struct PBf16ToF32 {
    const bf16* A; const float* B; float* C; int lda, ldb_, K_, M, ldc, pad;
    __device__ int rows(int) const { return M; } __device__ const float* b(int) const { return B; } __device__ int ldb() const { return ldb_; } __device__ int K() const { return K_; }
    __device__ float a(int, int m, int k) const { return bf2f(A[(size_t)m * lda + k]); }
    __device__ void store(int, int m, int n, float v) const { C[(size_t)m * ldc + n] = v; }
};
struct PBf16MulF32 {
    const bf16* A; const float* B; float* C; int lda, ldb_, K_, M, ldc, pad;
    __device__ int rows(int) const { return M; } __device__ const float* b(int) const { return B; } __device__ int ldb() const { return ldb_; } __device__ int K() const { return K_; }
    __device__ float a(int, int m, int k) const { return bf2f(A[(size_t)m * lda + k]); }
    __device__ void store(int, int m, int n, float v) const { C[(size_t)m * ldc + n] *= v; }
};
struct PBf16ToBf16 {
    const bf16* A; const float* B; bf16* C; int lda, ldb_, K_, M, ldc, transpose;
    __device__ int rows(int) const { return M; } __device__ const float* b(int) const { return B; } __device__ int ldb() const { return ldb_; } __device__ int K() const { return K_; }
    __device__ float a(int, int m, int k) const { return bf2f(A[(size_t)m * lda + k]); }
    __device__ void store(int, int m, int n, float v) const { if (transpose) C[(size_t)n * ldc + m] = (bf16)f2bf(v); else C[(size_t)m * ldc + n] = (bf16)f2bf(v); }
};
struct PResid {
    const bf16* A; const float* B; const float* X; float* Y; int lda, ldb_, K_, M;
    __device__ int rows(int) const { return M; } __device__ const float* b(int) const { return B; } __device__ int ldb() const { return ldb_; } __device__ int K() const { return K_; }
    __device__ float a(int, int m, int k) const { return bf2f(A[(size_t)m * lda + k]); }
    __device__ void store(int, int m, int n, float v) const { Y[(size_t)m * DM + n] = ALPHA * X[(size_t)m * DM + n] + v; }
};
struct PPool {
    const float* D; const float* W; const float* scale; bf16* cat;
    __device__ int rows(int) const { return NTOK; } __device__ const float* b(int z) const { return W + (size_t)z * 128 * 128; } __device__ int ldb() const { return 128; } __device__ int K() const { return 128; }
    __device__ float a(int z, int m, int k) const { return D[(size_t)m * 512 + z * 128 + k]; }
    __device__ void store(int z, int m, int n, float v) const { cat[(size_t)m * DM + z * 128 + n] = (bf16)f2bf(v * scale[z * 128 + n]); }
};
struct PMoe1 {
    const bf16* xb; const int* list; const unsigned* cnt; const unsigned* off; const float* W; float* hid; int mode, pad;
    __device__ int rows(int z) const { return (int)cnt[z]; } __device__ const float* b(int z) const { return W + (size_t)z * DM * DEXP; } __device__ int ldb() const { return DEXP; } __device__ int K() const { return DM; }
    __device__ float a(int z, int m, int k) const { const int slot = list[(size_t)z * LIST_CAP + m]; return bf2f(xb[(size_t)(slot >> 1) * DM + k]); }
    __device__ void store(int z, int m, int n, float v) const { float* h = hid + (size_t)(off[z] + m) * DEXP + n; if (mode == 0) *h = v; else { const float g = *h; *h = g / (1.f + __expf(-g)) * v; } }
};
struct PMoe2 {
    const float* hid; const int* list; const unsigned* cnt; const unsigned* off; const float* W; const float* gate; bf16* out2;
    __device__ int rows(int z) const { return (int)cnt[z]; } __device__ const float* b(int z) const { return W + (size_t)z * DEXP * DM; } __device__ int ldb() const { return DM; } __device__ int K() const { return DEXP; }
    __device__ float a(int z, int m, int k) const { return hid[(size_t)(off[z] + m) * DEXP + k]; }
    __device__ void store(int z, int m, int n, float v) const { const int slot = list[(size_t)z * LIST_CAP + m]; out2[(size_t)slot * DM + n] = (bf16)f2bf(v * gate[slot]); }
};

__global__ void k_cvt(const float* in, float* outf, bf16* outb, size_t n) {
    for (size_t i = (size_t)blockIdx.x * blockDim.x + threadIdx.x; i < n; i += (size_t)gridDim.x * blockDim.x) { const float v = in[i]; if (outf) outf[i] = v; outb[i] = (bf16)f2bf(v); }
}
__device__ __forceinline__ float wave_sum(float v) {
#pragma unroll
    for (int o = 1; o < 64; o <<= 1) v += __shfl_xor(v, o);
    return v;
}
__device__ __forceinline__ float gelu_tanh(float x) { const float u = 0.7978845608028654f * (x + 0.044715f * x * x * x); return 0.5f * x * (1.f + tanhf(u)); }

__global__ __launch_bounds__(256) void k_ln(const float* Y, const float* resid, const bf16* add2, const float* g, const float* b, float* xf, bf16* xb, float* xf2) {
    const int row = blockIdx.x * 4 + (threadIdx.x >> 6), lane = threadIdx.x & 63;
    float v[16]; float s = 0.f;
#pragma unroll
    for (int j = 0; j < 16; ++j) { const int c = lane + 64 * j; float t;
        if (add2) t = ALPHA * resid[(size_t)row * DM + c] + bf2f(add2[(size_t)(2 * row) * DM + c]) + bf2f(add2[(size_t)(2 * row + 1) * DM + c]);
        else t = Y[(size_t)row * DM + c];
        v[j] = t; s += t; }
    const float mean = wave_sum(s) * (1.f / DM); float q = 0.f;
#pragma unroll
    for (int j = 0; j < 16; ++j) { const float d = v[j] - mean; q += d * d; }
    const float rstd = 1.f / sqrtf(wave_sum(q) * (1.f / DM) + LN_EPS);
#pragma unroll
    for (int j = 0; j < 16; ++j) { const int c = lane + 64 * j; const float o = (v[j] - mean) * rstd * g[c] + b[c]; xf[(size_t)row * DM + c] = o; xb[(size_t)row * DM + c] = (bf16)f2bf(o); if (xf2) xf2[(size_t)row * DM + c] = o; }
}

__global__ void k_even_pool(const float* Hf, float* D) {
    const size_t i = (size_t)blockIdx.x * blockDim.x + threadIdx.x; if (i >= (size_t)NTOK * 512) return;
    const int t = (int)(i / 512), ch = (int)(i % 512), g = ch / 128, w = 2 << g, s = t % SEQ, cnt = (s + 1 < w) ? s + 1 : w;
    float sum = 0.f; for (int j = 0; j < cnt; ++j) sum += Hf[(size_t)(t - j) * DIN_E + ch];
    D[i] = sum / (float)cnt - Hf[(size_t)t * DIN_E + ch];
}
__global__ __launch_bounds__(256) void k_even_gelu_ln(float* Hf, const float* lg, const float* lb) {
    const int row = blockIdx.x * 4 + (threadIdx.x >> 6), lane = threadIdx.x & 63;
    float* h = Hf + (size_t)row * DIN_E;
    for (int j = 0; j < 8; ++j) { const int c = 512 + lane + 64 * j; h[c] = gelu_tanh(h[c]); }
    float v[8]; float s = 0.f;
#pragma unroll
    for (int j = 0; j < 8; ++j) { v[j] = gelu_tanh(h[1024 + lane + 64 * j]); s += v[j]; }
    const float mean = wave_sum(s) * (1.f / 512.f); float q = 0.f;
#pragma unroll
    for (int j = 0; j < 8; ++j) { const float d = v[j] - mean; q += d * d; }
    const float rstd = 1.f / sqrtf(wave_sum(q) * (1.f / 512.f) + LN_EPS);
#pragma unroll
    for (int j = 0; j < 8; ++j) { const int c = lane + 64 * j; h[1024 + c] = (v[j] - mean) * rstd * lg[c] + lb[c]; }
}
__global__ void k_even_gate(const float* Hf, const float* wsp, const float* bsp, bf16* cat) {
    const size_t idx = (size_t)blockIdx.x * blockDim.x + threadIdx.x; if (idx >= (size_t)NTOK * 512) return;
    const int t = (int)(idx / 512), hc = (int)(idx % 512), h = hc / 128, i = t % CHUNK, tb = t - i;
    const float* wrow = wsp + ((size_t)h * CHUNK + i) * CHUNK;
    float sv = 0.f; for (int j = 0; j <= i; ++j) sv += wrow[j] * Hf[(size_t)(tb + j) * DIN_E + 1024 + hc];
    sv += bsp[h * CHUNK + i];
    cat[(size_t)t * DM + 512 + hc] = (bf16)f2bf(Hf[(size_t)t * DIN_E + 512 + hc] * sv);
}
__global__ void k_odd_conv(const float* zc, const float* bg, const float* cw, const float* cb, bf16* cat) {
    const size_t idx = (size_t)blockIdx.x * blockDim.x + threadIdx.x; if (idx >= (size_t)NTOK * DM) return;
    const int t = (int)(idx / DM), c = (int)(idx % DM), s = t % SEQ;
    float conv = cb[c] + zc[idx] * cw[c * 3 + 2];
    if (s >= 1) conv += zc[idx - DM] * cw[c * 3 + 1];
    if (s >= 2) conv += zc[idx - 2 * DM] * cw[c * 3 + 0];
    cat[idx] = (bf16)f2bf(bg[idx] * conv);
}
__global__ __launch_bounds__(256) void k_attn(const bf16* q, const bf16* K, const bf16* VT, bf16* o) {
    __shared__ float qs[256]; __shared__ float ps[256]; __shared__ float red[8];
    const int t = blockIdx.x, h = blockIdx.y, b = t / SEQ, tid = threadIdx.x, lane = tid & 63, w = tid >> 6;
    qs[tid] = bf2f(q[(size_t)t * DM + h * XHD + tid]);
    __syncthreads();
    const uint4* kr = (const uint4*)(K + (size_t)(b * MEM + tid) * DM + h * XHD);
    float s = 0.f;
    for (int d8 = 0; d8 < XHD / 8; ++d8) { const uint4 kv = kr[d8]; const unsigned w4[4] = {kv.x, kv.y, kv.z, kv.w};
#pragma unroll
        for (int j = 0; j < 4; ++j) { s += qs[d8 * 8 + 2 * j] * __builtin_bit_cast(float, w4[j] << 16); s += qs[d8 * 8 + 2 * j + 1] * __builtin_bit_cast(float, w4[j] & 0xffff0000u); } }
    s *= 0.0625f;
    float m = s;
#pragma unroll
    for (int off = 1; off < 64; off <<= 1) m = fmaxf(m, __shfl_xor(m, off));
    if (lane == 0) red[w] = m;
    __syncthreads();
    m = fmaxf(fmaxf(red[0], red[1]), fmaxf(red[2], red[3]));
    const float e = __expf(s - m);
    float sum = wave_sum(e);
    if (lane == 0) red[4 + w] = sum;
    ps[tid] = e;
    __syncthreads();
    sum = red[4] + red[5] + red[6] + red[7];
    const uint4* vr = (const uint4*)(VT + (size_t)(h * XHD + tid) * NMEM + b * MEM);
    float acc = 0.f;
    for (int j8 = 0; j8 < MEM / 8; ++j8) { const uint4 vv = vr[j8]; const unsigned w4[4] = {vv.x, vv.y, vv.z, vv.w};
#pragma unroll
        for (int j = 0; j < 4; ++j) { acc += ps[j8 * 8 + 2 * j] * __builtin_bit_cast(float, w4[j] << 16); acc += ps[j8 * 8 + 2 * j + 1] * __builtin_bit_cast(float, w4[j] & 0xffff0000u); } }
    o[(size_t)t * DM + h * XHD + tid] = (bf16)f2bf(acc / sum);
}
__global__ __launch_bounds__(256) void k_router(const float* x, const float* wrg, const float* brg, const float* wre, const float* bre, unsigned* cnt, int* list, float* gate) {
    const int t = blockIdx.x * 4 + (threadIdx.x >> 6), lane = threadIdx.x & 63;
    float g0 = 0.f, g1 = 0.f, g2 = 0.f, g3 = 0.f;
    for (int k = lane; k < DM; k += 64) { const float xv = x[(size_t)t * DM + k]; const float4 w = *(const float4*)(wrg + k * 4); g0 += xv * w.x; g1 += xv * w.y; g2 += xv * w.z; g3 += xv * w.w; }
    g0 = wave_sum(g0) + brg[0]; g1 = wave_sum(g1) + brg[1]; g2 = wave_sum(g2) + brg[2]; g3 = wave_sum(g3) + brg[3];
    int gs = 0; float gm = g0;
    if (g1 > gm) { gm = g1; gs = 1; }
    if (g2 > gm) { gm = g2; gs = 2; }
    if (g3 > gm) { gm = g3; gs = 3; }
    gs = __builtin_amdgcn_readfirstlane(gs);
    const float gate_g = 1.f / (__expf(g0 - gm) + __expf(g1 - gm) + __expf(g2 - gm) + __expf(g3 - gm));
    float e0 = 0.f, e1 = 0.f, e2 = 0.f, e3 = 0.f, e4 = 0.f, e5 = 0.f, e6 = 0.f, e7 = 0.f;
    const float* we = wre + (size_t)gs * DM * 8;
    for (int k = lane; k < DM; k += 64) { const float xv = x[(size_t)t * DM + k]; const float4 wa = *(const float4*)(we + k * 8), wb = *(const float4*)(we + k * 8 + 4);
        e0 += xv * wa.x; e1 += xv * wa.y; e2 += xv * wa.z; e3 += xv * wa.w; e4 += xv * wb.x; e5 += xv * wb.y; e6 += xv * wb.z; e7 += xv * wb.w; }
    const float* be = bre + gs * 8;
    e0 = wave_sum(e0) + be[0]; e1 = wave_sum(e1) + be[1]; e2 = wave_sum(e2) + be[2]; e3 = wave_sum(e3) + be[3];
    e4 = wave_sum(e4) + be[4]; e5 = wave_sum(e5) + be[5]; e6 = wave_sum(e6) + be[6]; e7 = wave_sum(e7) + be[7];
    int i1 = 0; float v1 = e0;
    if (e1 > v1) { v1 = e1; i1 = 1; } if (e2 > v1) { v1 = e2; i1 = 2; } if (e3 > v1) { v1 = e3; i1 = 3; }
    if (e4 > v1) { v1 = e4; i1 = 4; } if (e5 > v1) { v1 = e5; i1 = 5; } if (e6 > v1) { v1 = e6; i1 = 6; } if (e7 > v1) { v1 = e7; i1 = 7; }
    int i2 = -1; float v2 = -3.0e38f;
    if (i1 != 0 && e0 > v2) { v2 = e0; i2 = 0; } if (i1 != 1 && e1 > v2) { v2 = e1; i2 = 1; } if (i1 != 2 && e2 > v2) { v2 = e2; i2 = 2; } if (i1 != 3 && e3 > v2) { v2 = e3; i2 = 3; }
    if (i1 != 4 && e4 > v2) { v2 = e4; i2 = 4; } if (i1 != 5 && e5 > v2) { v2 = e5; i2 = 5; } if (i1 != 6 && e6 > v2) { v2 = e6; i2 = 6; } if (i1 != 7 && e7 > v2) { v2 = e7; i2 = 7; }
    if (lane == 0) {
        const float ex = __expf(v2 - v1), w1 = 1.f / (1.f + ex), w2 = ex / (1.f + ex);
        const int x1 = gs * 8 + i1, x2 = gs * 8 + i2;
        gate[2 * t] = gate_g * w1; gate[2 * t + 1] = gate_g * w2;
        const unsigned p1 = atomicAdd(cnt + x1, 1u); list[(size_t)x1 * LIST_CAP + p1] = 2 * t;
        const unsigned p2 = atomicAdd(cnt + x2, 1u); list[(size_t)x2 * LIST_CAP + p2] = 2 * t + 1;
    }
}
__global__ void k_offsets(const unsigned* cnt, unsigned* off) { if (threadIdx.x == 0 && blockIdx.x == 0) { unsigned a = 0; for (int e = 0; e < NEXP; ++e) { off[e] = a; a += (cnt[e] + 255u) / 256u * 256u; } off[NEXP] = a; } }

template <class P> static void ngemm(P p, int N, int Mmax, int Z, hipStream_t s) { static_assert(sizeof(P) % 8 == 0, "no tail padding"); hipLaunchKernelGGL(k_ngemm<P>, dim3(N / 128, (Mmax + 127) / 128, Z), dim3(256), 0, s, p); }

extern "C" void kernel_launch(void* const* d_in, const int* in_sizes, int n_in, void* d_out, int out_size, void* d_ws, size_t ws_size, hipStream_t stream) {
    if (n_in != 27 || out_size != NTOK * DM || ws_size < WS_END) { fprintf(stderr, "kernel_launch: unexpected shapes (n_in %d out %d ws %zu need %zu)\n", n_in, out_size, ws_size, (size_t)WS_END); return; }
    const float* in_x = (const float*)d_in[0]; const float* in_mem = (const float*)d_in[1];
    const float* w_in_even = (const float*)d_in[2]; const float* w_pool = (const float*)d_in[3]; const float* pool_scale = (const float*)d_in[4];
    const float* ln_v_g = (const float*)d_in[5]; const float* ln_v_b = (const float*)d_in[6]; const float* w_spatial = (const float*)d_in[7]; const float* b_spatial = (const float*)d_in[8];
    const float* w_out_even = (const float*)d_in[9]; const float* w_in_odd = (const float*)d_in[10]; const float* conv_w = (const float*)d_in[11]; const float* conv_b = (const float*)d_in[12];
    const float* w_out_odd = (const float*)d_in[13]; const float* wq = (const float*)d_in[14]; const float* wk = (const float*)d_in[15]; const float* wv = (const float*)d_in[16]; const float* wo = (const float*)d_in[17];
    const float* ln_g = (const float*)d_in[18]; const float* ln_b = (const float*)d_in[19]; const float* wr_group = (const float*)d_in[20]; const float* br_group = (const float*)d_in[21];
    const float* wr_expert = (const float*)d_in[22]; const float* br_expert = (const float*)d_in[23]; const float* w1 = (const float*)d_in[24]; const float* w3 = (const float*)d_in[25]; const float* w2 = (const float*)d_in[26];
    char* ws = (char*)d_ws;
    unsigned* ctl = (unsigned*)(ws + WS_CTL);
    float* X = (float*)(ws + WS_X); bf16* XB = (bf16*)(ws + WS_XB); float* Y = (float*)(ws + WS_Y); bf16* CAT = (bf16*)(ws + WS_CAT);
    bf16* KB = (bf16*)(ws + WS_KV); bf16* VTB = KB + (size_t)DEPTH * NMEM * DM; bf16* MEMB = (bf16*)(ws + WS_MEMB);
    int* LIST = (int*)(ws + WS_LIST); float* GATE = (float*)(ws + WS_GATE);
    char* SCR = ws + WS_SCR;
    (void)hipMemsetAsync(ctl, 0, CTL_BYTES, stream);
    hipLaunchKernelGGL(k_cvt, dim3(2048), dim3(256), 0, stream, in_x, X, XB, (size_t)NTOK * DM);
    hipLaunchKernelGGL(k_cvt, dim3(512), dim3(256), 0, stream, in_mem, (float*)nullptr, MEMB, (size_t)NMEM * DM);
    for (int l = 0; l < DEPTH; ++l) {
        ngemm(PBf16ToBf16{MEMB, wk + (size_t)l * DM * DM, KB + (size_t)l * NMEM * DM, DM, DM, DM, NMEM, DM, 0}, DM, NMEM, 1, stream);
        ngemm(PBf16ToBf16{MEMB, wv + (size_t)l * DM * DM, VTB + (size_t)l * DM * NMEM, DM, DM, DM, NMEM, NMEM, 1}, DM, NMEM, 1, stream);
    }
    for (int l = 0; l < DEPTH; ++l) {
        const int i = l / 2;
        if (l % 2 == 0) {
            float* Hf = (float*)SCR; float* D = (float*)(SCR + 96 * MiB);
            ngemm(PBf16ToF32{XB, w_in_even + (size_t)i * DM * DIN_E, Hf, DM, DIN_E, DM, NTOK, DIN_E, 0}, DIN_E, NTOK, 1, stream);
            hipLaunchKernelGGL(k_even_pool, dim3(NTOK * 512 / 256), dim3(256), 0, stream, Hf, D);
            ngemm(PPool{D, w_pool + (size_t)i * 4 * 128 * 128, pool_scale + (size_t)i * 512, CAT}, 128, NTOK, 4, stream);
            hipLaunchKernelGGL(k_even_gelu_ln, dim3(NTOK / 4), dim3(256), 0, stream, Hf, ln_v_g + (size_t)i * 512, ln_v_b + (size_t)i * 512);
            hipLaunchKernelGGL(k_even_gate, dim3(NTOK * 512 / 256), dim3(256), 0, stream, Hf, w_spatial + (size_t)i * 4 * 128 * 128, b_spatial + (size_t)i * 4 * 128, CAT);
            ngemm(PResid{CAT, w_out_even + (size_t)i * DM * DM, X, Y, DM, DM, DM, NTOK}, DM, NTOK, 1, stream);
        } else {
            float* ZC = (float*)SCR; float* BG = (float*)(SCR + 64 * MiB);
            const float* W = w_in_odd + (size_t)i * DM * DIN_O;
            ngemm(PBf16ToF32{XB, W + DM, ZC, DM, DIN_O, DM, NTOK, DM, 0}, DM, NTOK, 1, stream);
            ngemm(PBf16MulF32{XB, W + 2 * DM, ZC, DM, DIN_O, DM, NTOK, DM, 0}, DM, NTOK, 1, stream);
            ngemm(PBf16ToF32{XB, W, BG, DM, DIN_O, DM, NTOK, DM, 0}, DM, NTOK, 1, stream);
            hipLaunchKernelGGL(k_odd_conv, dim3(NTOK * DM / 256), dim3(256), 0, stream, ZC, BG, conv_w + (size_t)i * DM * 3, conv_b + (size_t)i * DM, CAT);
            ngemm(PResid{CAT, w_out_odd + (size_t)i * DM * DM, X, Y, DM, DM, DM, NTOK}, DM, NTOK, 1, stream);
        }
        hipLaunchKernelGGL(k_ln, dim3(NTOK / 4), dim3(256), 0, stream, Y, (const float*)nullptr, (const bf16*)nullptr, ln_g + (size_t)(l * 3 + 0) * DM, ln_b + (size_t)(l * 3 + 0) * DM, X, XB, (float*)nullptr);
        bf16* Q = (bf16*)SCR; bf16* O = (bf16*)(SCR + 32 * MiB);
        ngemm(PBf16ToBf16{XB, wq + (size_t)l * DM * DM, Q, DM, DM, DM, NTOK, DM, 0}, DM, NTOK, 1, stream);
        hipLaunchKernelGGL(k_attn, dim3(NTOK, NXH), dim3(256), 0, stream, Q, KB + (size_t)l * NMEM * DM, VTB + (size_t)l * DM * NMEM, O);
        ngemm(PResid{O, wo + (size_t)l * DM * DM, X, Y, DM, DM, DM, NTOK}, DM, NTOK, 1, stream);
        hipLaunchKernelGGL(k_ln, dim3(NTOK / 4), dim3(256), 0, stream, Y, (const float*)nullptr, (const bf16*)nullptr, ln_g + (size_t)(l * 3 + 1) * DM, ln_b + (size_t)(l * 3 + 1) * DM, X, XB, (float*)nullptr);
        unsigned* cnt = ctl + CW_CNT + l * NEXP; unsigned* off = ctl + CW_OFF + l * (NEXP + 1);
        hipLaunchKernelGGL(k_router, dim3(NTOK / 4), dim3(256), 0, stream, X, wr_group + (size_t)l * DM * 4, br_group + (size_t)l * 4, wr_expert + (size_t)l * 4 * DM * 8, br_expert + (size_t)l * 32, cnt, LIST, GATE);
        hipLaunchKernelGGL(k_offsets, dim3(1), dim3(64), 0, stream, cnt, off);
        float* HID = (float*)SCR; bf16* OUT2 = (bf16*)(SCR + 96 * MiB);
        ngemm(PMoe1{XB, LIST, cnt, off, w1 + (size_t)l * NEXP * DM * DEXP, HID, 0, 0}, DEXP, NTOK, NEXP, stream);
        ngemm(PMoe1{XB, LIST, cnt, off, w3 + (size_t)l * NEXP * DM * DEXP, HID, 1, 0}, DEXP, NTOK, NEXP, stream);
        ngemm(PMoe2{HID, LIST, cnt, off, w2 + (size_t)l * NEXP * DEXP * DM, GATE, OUT2}, DM, NTOK, NEXP, stream);
        hipLaunchKernelGGL(k_ln, dim3(NTOK / 4), dim3(256), 0, stream, (const float*)nullptr, X, OUT2, ln_g + (size_t)(l * 3 + 2) * DM, ln_b + (size_t)(l * 3 + 2) * DM, X, XB, (l == DEPTH - 1) ? (float*)d_out : (float*)nullptr);
    }
}
```

```cpp
#include <hip/hip_runtime.h>
#include <cstdio>
#include <cstdint>
#include <cstddef>

typedef unsigned short bf16;
__device__ __forceinline__ unsigned f2bf(float f) { unsigned u = __builtin_bit_cast(unsigned, f); return (u + 0x7fffu + ((u >> 16) & 1u)) >> 16; }
__device__ __forceinline__ float bf2f(bf16 b) { return __builtin_bit_cast(float, ((unsigned)b) << 16); }

constexpr int DM = 1024, BATCH = 4, SEQ = 4096, NTOK = BATCH * SEQ, DEPTH = 4, MEM = 256, NMEM = BATCH * MEM;
constexpr int DPOOL = 512, DSG = 512, NHSG = 4, CHUNK = 128, DIN_E = DPOOL + 2 * DSG, DIN_O = 3 * DM;
constexpr int NXH = 4, XHD = 256, NGRP = 4, EPG = 8, NEXP = 32, DEXP = 512;
constexpr float ALPHA = 1.6817928305074290f;
constexpr float LN_EPS = 1e-5f;
constexpr int LIST_CAP = NTOK;

constexpr size_t MiB = 1u << 20;
constexpr size_t WS_CTL = 0, CTL_BYTES = 1 * MiB;
constexpr size_t WS_X = 1 * MiB;
constexpr size_t WS_XB = WS_X + 64 * MiB;
constexpr size_t WS_Y = WS_XB + 32 * MiB;
constexpr size_t WS_CAT = WS_Y + 64 * MiB;
constexpr size_t WS_KV = WS_CAT + 32 * MiB;
constexpr size_t WS_MEMB = WS_KV + 16 * MiB;
constexpr size_t WS_LIST = WS_MEMB + 2 * MiB;
constexpr size_t WS_GATE = WS_LIST + 2 * MiB;
constexpr size_t WS_SCR = WS_GATE + 1 * MiB;
constexpr size_t WS_END = WS_SCR + 160 * MiB;
constexpr int CW_CNT = 1024;
constexpr int CW_OFF = 2048;

template <class P>
__global__ __launch_bounds__(256) void k_ngemm(P p) {
    __shared__ float As[16][132];
    __shared__ float Bs[16][132];
    const int z = blockIdx.z, m0 = blockIdx.y * 128, n0 = blockIdx.x * 128;
    const int rows = p.rows(z);
    if (m0 >= rows) return;
    const float* B = p.b(z); const int ldb = p.ldb(); const int K = p.K();
    const int tid = threadIdx.x, tx = tid & 15, ty = tid >> 4;
    float acc[8][8];
#pragma unroll
    for (int i = 0; i < 8; ++i)
#pragma unroll
        for (int j = 0; j < 8; ++j) acc[i][j] = 0.f;
    for (int k0 = 0; k0 < K; k0 += 16) {
#pragma unroll
        for (int i = 0; i < 8; ++i) { const int idx = tid + i * 256, r = idx >> 4, kk = idx & 15; As[kk][r] = (m0 + r < rows) ? p.a(z, m0 + r, k0 + kk) : 0.f; }
#pragma unroll
        for (int i = 0; i < 8; ++i) { const int idx = tid + i * 256, kk = idx >> 7, n = idx & 127; Bs[kk][n] = B[(size_t)(k0 + kk) * ldb + n0 + n]; }
        __syncthreads();
#pragma unroll
        for (int kk = 0; kk < 16; ++kk) {
            float a[8], b[8];
#pragma unroll
            for (int i = 0; i < 8; ++i) a[i] = As[kk][ty + 16 * i];
#pragma unroll
            for (int j = 0; j < 8; ++j) b[j] = Bs[kk][tx + 16 * j];
#pragma unroll
            for (int i = 0; i < 8; ++i)
#pragma unroll
                for (int j = 0; j < 8; ++j) acc[i][j] += a[i] * b[j];
        }
        __syncthreads();
    }
#pragma unroll
    for (int i = 0; i < 8; ++i) { const int m = m0 + ty + 16 * i; if (m < rows) {
#pragma unroll
        for (int j = 0; j < 8; ++j) p.store(z, m, n0 + tx + 16 * j, acc[i][j]); } }
}

struct PBf16ToF32 {
    const bf16* A; const float* B; float* C; int lda, ldb_, K_, M, ldc, pad;
    __device__ int rows(int) const { return M; } __device__ const float* b(int) const { return B; } __device__ int ldb() const { return ldb_; } __device__ int K() const { return K_; }
    __device__ float a(int, int m, int k) const { return bf2f(A[(size_t)m * lda + k]); }
    __device__ void store(int, int m, int n, float v) const { C[(size_t)m * ldc + n] = v; }
};
struct PBf16MulF32 {
    const bf16* A; const float* B; float* C; int lda, ldb_, K_, M, ldc, pad;
    __device__ int rows(int) const { return M; } __device__ const float* b(int) const { return B; } __device__ int ldb() const { return ldb_; } __device__ int K() const { return K_; }
    __device__ float a(int, int m, int k) const { return bf2f(A[(size_t)m * lda + k]); }
    __device__ void store(int, int m, int n, float v) const { C[(size_t)m * ldc + n] *= v; }
};
struct PBf16ToBf16 {
    const bf16* A; const float* B; bf16* C; int lda, ldb_, K_, M, ldc, transpose;
    __device__ int rows(int) const { return M; } __device__ const float* b(int) const { return B; } __device__ int ldb() const { return ldb_; } __device__ int K() const { return K_; }
    __device__ float a(int, int m, int k) const { return bf2f(A[(size_t)m * lda + k]); }
    __device__ void store(int, int m, int n, float v) const { if (transpose) C[(size_t)n * ldc + m] = (bf16)f2bf(v); else C[(size_t)m * ldc + n] = (bf16)f2bf(v); }
};
struct PResid {
    const bf16* A; const float* B; const float* X; float* Y; int lda, ldb_, K_, M;
    __device__ int rows(int) const { return M; } __device__ const float* b(int) const { return B; } __device__ int ldb() const { return ldb_; } __device__ int K() const { return K_; }
    __device__ float a(int, int m, int k) const { return bf2f(A[(size_t)m * lda + k]); }
    __device__ void store(int, int m, int n, float v) const { Y[(size_t)m * DM + n] = ALPHA * X[(size_t)m * DM + n] + v; }
};
struct PPool {
    const float* D; const float* W; const float* scale; bf16* cat;
    __device__ int rows(int) const { return NTOK; } __device__ const float* b(int z) const { return W + (size_t)z * 128 * 128; } __device__ int ldb() const { return 128; } __device__ int K() const { return 128; }
    __device__ float a(int z, int m, int k) const { return D[(size_t)m * 512 + z * 128 + k]; }
    __device__ void store(int z, int m, int n, float v) const { cat[(size_t)m * DM + z * 128 + n] = (bf16)f2bf(v * scale[z * 128 + n]); }
};
struct PMoe1 {
    const bf16* xb; const int* list; const unsigned* cnt; const unsigned* off; const float* W; float* hid; int mode, pad;
    __device__ int rows(int z) const { return (int)cnt[z]; } __device__ const float* b(int z) const { return W + (size_t)z * DM * DEXP; } __device__ int ldb() const { return DEXP; } __device__ int K() const { return DM; }
    __device__ float a(int z, int m, int k) const { const int slot = list[(size_t)z * LIST_CAP + m]; return bf2f(xb[(size_t)(slot >> 1) * DM + k]); }
    __device__ void store(int z, int m, int n, float v) const { float* h = hid + (size_t)(off[z] + m) * DEXP + n; if (mode == 0) *h = v; else { const float g = *h; *h = g / (1.f + __expf(-g)) * v; } }
};
struct PMoe2 {
    const float* hid; const int* list; const unsigned* cnt; const unsigned* off; const float* W; const float* gate; bf16* out2;
    __device__ int rows(int z) const { return (int)cnt[z]; } __device__ const float* b(int z) const { return W + (size_t)z * DEXP * DM; } __device__ int ldb() const { return DM; } __device__ int K() const { return DEXP; }
    __device__ float a(int z, int m, int k) const { return hid[(size_t)(off[z] + m) * DEXP + k]; }
    __device__ void store(int z, int m, int n, float v) const { const int slot = list[(size_t)z * LIST_CAP + m]; out2[(size_t)slot * DM + n] = (bf16)f2bf(v * gate[slot]); }
};

__global__ void k_cvt(const float* in, float* outf, bf16* outb, size_t n) {
    for (size_t i = (size_t)blockIdx.x * blockDim.x + threadIdx.x; i < n; i += (size_t)gridDim.x * blockDim.x) { const float v = in[i]; if (outf) outf[i] = v; outb[i] = (bf16)f2bf(v); }
}
__device__ __forceinline__ float wave_sum(float v) {
#pragma unroll
    for (int o = 1; o < 64; o <<= 1) v += __shfl_xor(v, o);
    return v;
}
__device__ __forceinline__ float gelu_tanh(float x) { const float u = 0.7978845608028654f * (x + 0.044715f * x * x * x); return 0.5f * x * (1.f + tanhf(u)); }

__global__ __launch_bounds__(256) void k_ln(const float* Y, const float* resid, const bf16* add2, const float* g, const float* b, float* xf, bf16* xb, float* xf2) {
    const int row = blockIdx.x * 4 + (threadIdx.x >> 6), lane = threadIdx.x & 63;
    float v[16]; float s = 0.f;
#pragma unroll
    for (int j = 0; j < 16; ++j) { const int c = lane + 64 * j; float t;
        if (add2) t = ALPHA * resid[(size_t)row * DM + c] + bf2f(add2[(size_t)(2 * row) * DM + c]) + bf2f(add2[(size_t)(2 * row + 1) * DM + c]);
        else t = Y[(size_t)row * DM + c];
        v[j] = t; s += t; }
    const float mean = wave_sum(s) * (1.f / DM); float q = 0.f;
#pragma unroll
    for (int j = 0; j < 16; ++j) { const float d = v[j] - mean; q += d * d; }
    const float rstd = 1.f / sqrtf(wave_sum(q) * (1.f / DM) + LN_EPS);
#pragma unroll
    for (int j = 0; j < 16; ++j) { const int c = lane + 64 * j; const float o = (v[j] - mean) * rstd * g[c] + b[c]; xf[(size_t)row * DM + c] = o; xb[(size_t)row * DM + c] = (bf16)f2bf(o); if (xf2) xf2[(size_t)row * DM + c] = o; }
}

__global__ void k_even_pool(const float* Hf, float* D) {
    const size_t i = (size_t)blockIdx.x * blockDim.x + threadIdx.x; if (i >= (size_t)NTOK * 512) return;
    const int t = (int)(i / 512), ch = (int)(i % 512), g = ch / 128, w = 2 << g, s = t % SEQ, cnt = (s + 1 < w) ? s + 1 : w;
    float sum = 0.f; for (int j = 0; j < cnt; ++j) sum += Hf[(size_t)(t - j) * DIN_E + ch];
    D[i] = sum / (float)cnt - Hf[(size_t)t * DIN_E + ch];
}
__global__ __launch_bounds__(256) void k_even_gelu_ln(float* Hf, const float* lg, const float* lb) {
    const int row = blockIdx.x * 4 + (threadIdx.x >> 6), lane = threadIdx.x & 63;
    float* h = Hf + (size_t)row * DIN_E;
    for (int j = 0; j < 8; ++j) { const int c = 512 + lane + 64 * j; h[c] = gelu_tanh(h[c]); }
    float v[8]; float s = 0.f;
#pragma unroll
    for (int j = 0; j < 8; ++j) { v[j] = gelu_tanh(h[1024 + lane + 64 * j]); s += v[j]; }
    const float mean = wave_sum(s) * (1.f / 512.f); float q = 0.f;
#pragma unroll
    for (int j = 0; j < 8; ++j) { const float d = v[j] - mean; q += d * d; }
    const float rstd = 1.f / sqrtf(wave_sum(q) * (1.f / 512.f) + LN_EPS);
#pragma unroll
    for (int j = 0; j < 8; ++j) { const int c = lane + 64 * j; h[1024 + c] = (v[j] - mean) * rstd * lg[c] + lb[c]; }
}
__global__ void k_even_gate(const float* Hf, const float* wsp, const float* bsp, bf16* cat) {
    const size_t idx = (size_t)blockIdx.x * blockDim.x + threadIdx.x; if (idx >= (size_t)NTOK * 512) return;
    const int t = (int)(idx / 512), hc = (int)(idx % 512), h = hc / 128, i = t % CHUNK, tb = t - i;
    const float* wrow = wsp + ((size_t)h * CHUNK + i) * CHUNK;
    float sv = 0.f; for (int j = 0; j <= i; ++j) sv += wrow[j] * Hf[(size_t)(tb + j) * DIN_E + 1024 + hc];
    sv += bsp[h * CHUNK + i];
    cat[(size_t)t * DM + 512 + hc] = (bf16)f2bf(Hf[(size_t)t * DIN_E + 512 + hc] * sv);
}
__global__ void k_odd_conv(const float* zc, const float* bg, const float* cw, const float* cb, bf16* cat) {
    const size_t idx = (size_t)blockIdx.x * blockDim.x + threadIdx.x; if (idx >= (size_t)NTOK * DM) return;
    const int t = (int)(idx / DM), c = (int)(idx % DM), s = t % SEQ;
    float conv = cb[c] + zc[idx] * cw[c * 3 + 2];
    if (s >= 1) conv += zc[idx - DM] * cw[c * 3 + 1];
    if (s >= 2) conv += zc[idx - 2 * DM] * cw[c * 3 + 0];
    cat[idx] = (bf16)f2bf(bg[idx] * conv);
}
__global__ __launch_bounds__(256) void k_attn(const bf16* q, const bf16* K, int ldk, const bf16* VT, bf16* o) {
    __shared__ float qs[256]; __shared__ float ps[256]; __shared__ float red[8];
    const int t = blockIdx.x, h = blockIdx.y, b = t / SEQ, tid = threadIdx.x, lane = tid & 63, w = tid >> 6;
    qs[tid] = bf2f(q[(size_t)t * DM + h * XHD + tid]);
    __syncthreads();
    const uint4* kr = (const uint4*)(K + (size_t)(b * MEM + tid) * ldk + h * XHD);
    float s = 0.f;
    for (int d8 = 0; d8 < XHD / 8; ++d8) { const uint4 kv = kr[d8]; const unsigned w4[4] = {kv.x, kv.y, kv.z, kv.w};
#pragma unroll
        for (int j = 0; j < 4; ++j) { s += qs[d8 * 8 + 2 * j] * __builtin_bit_cast(float, w4[j] << 16); s += qs[d8 * 8 + 2 * j + 1] * __builtin_bit_cast(float, w4[j] & 0xffff0000u); } }
    s *= 0.0625f;
    float m = s;
#pragma unroll
    for (int off = 1; off < 64; off <<= 1) m = fmaxf(m, __shfl_xor(m, off));
    if (lane == 0) red[w] = m;
    __syncthreads();
    m = fmaxf(fmaxf(red[0], red[1]), fmaxf(red[2], red[3]));
    const float e = __expf(s - m);
    float sum = wave_sum(e);
    if (lane == 0) red[4 + w] = sum;
    ps[tid] = e;
    __syncthreads();
    sum = red[4] + red[5] + red[6] + red[7];
    const uint4* vr = (const uint4*)(VT + (size_t)(h * XHD + tid) * NMEM + b * MEM);
    float acc = 0.f;
    for (int j8 = 0; j8 < MEM / 8; ++j8) { const uint4 vv = vr[j8]; const unsigned w4[4] = {vv.x, vv.y, vv.z, vv.w};
#pragma unroll
        for (int j = 0; j < 4; ++j) { acc += ps[j8 * 8 + 2 * j] * __builtin_bit_cast(float, w4[j] << 16); acc += ps[j8 * 8 + 2 * j + 1] * __builtin_bit_cast(float, w4[j] & 0xffff0000u); } }
    o[(size_t)t * DM + h * XHD + tid] = (bf16)f2bf(acc / sum);
}
__global__ __launch_bounds__(256) void k_router(const float* x, const float* wrg, const float* brg, const float* wre, const float* bre, unsigned* cnt, int* list, float* gate) {
    const int t = blockIdx.x * 4 + (threadIdx.x >> 6), lane = threadIdx.x & 63;
    float g0 = 0.f, g1 = 0.f, g2 = 0.f, g3 = 0.f;
    for (int k = lane; k < DM; k += 64) { const float xv = x[(size_t)t * DM + k]; const float4 w = *(const float4*)(wrg + k * 4); g0 += xv * w.x; g1 += xv * w.y; g2 += xv * w.z; g3 += xv * w.w; }
    g0 = wave_sum(g0) + brg[0]; g1 = wave_sum(g1) + brg[1]; g2 = wave_sum(g2) + brg[2]; g3 = wave_sum(g3) + brg[3];
    int gs = 0; float gm = g0;
    if (g1 > gm) { gm = g1; gs = 1; }
    if (g2 > gm) { gm = g2; gs = 2; }
    if (g3 > gm) { gm = g3; gs = 3; }
    gs = __builtin_amdgcn_readfirstlane(gs);
    const float gate_g = 1.f / (__expf(g0 - gm) + __expf(g1 - gm) + __expf(g2 - gm) + __expf(g3 - gm));
    float e0 = 0.f, e1 = 0.f, e2 = 0.f, e3 = 0.f, e4 = 0.f, e5 = 0.f, e6 = 0.f, e7 = 0.f;
    const float* we = wre + (size_t)gs * DM * 8;
    for (int k = lane; k < DM; k += 64) { const float xv = x[(size_t)t * DM + k]; const float4 wa = *(const float4*)(we + k * 8), wb = *(const float4*)(we + k * 8 + 4);
        e0 += xv * wa.x; e1 += xv * wa.y; e2 += xv * wa.z; e3 += xv * wa.w; e4 += xv * wb.x; e5 += xv * wb.y; e6 += xv * wb.z; e7 += xv * wb.w; }
    const float* be = bre + gs * 8;
    e0 = wave_sum(e0) + be[0]; e1 = wave_sum(e1) + be[1]; e2 = wave_sum(e2) + be[2]; e3 = wave_sum(e3) + be[3];
    e4 = wave_sum(e4) + be[4]; e5 = wave_sum(e5) + be[5]; e6 = wave_sum(e6) + be[6]; e7 = wave_sum(e7) + be[7];
    int i1 = 0; float v1 = e0;
    if (e1 > v1) { v1 = e1; i1 = 1; } if (e2 > v1) { v1 = e2; i1 = 2; } if (e3 > v1) { v1 = e3; i1 = 3; }
    if (e4 > v1) { v1 = e4; i1 = 4; } if (e5 > v1) { v1 = e5; i1 = 5; } if (e6 > v1) { v1 = e6; i1 = 6; } if (e7 > v1) { v1 = e7; i1 = 7; }
    int i2 = -1; float v2 = -3.0e38f;
    if (i1 != 0 && e0 > v2) { v2 = e0; i2 = 0; } if (i1 != 1 && e1 > v2) { v2 = e1; i2 = 1; } if (i1 != 2 && e2 > v2) { v2 = e2; i2 = 2; } if (i1 != 3 && e3 > v2) { v2 = e3; i2 = 3; }
    if (i1 != 4 && e4 > v2) { v2 = e4; i2 = 4; } if (i1 != 5 && e5 > v2) { v2 = e5; i2 = 5; } if (i1 != 6 && e6 > v2) { v2 = e6; i2 = 6; } if (i1 != 7 && e7 > v2) { v2 = e7; i2 = 7; }
    if (lane == 0) {
        const float ex = __expf(v2 - v1), w1 = 1.f / (1.f + ex), w2 = ex / (1.f + ex);
        const int x1 = gs * 8 + i1, x2 = gs * 8 + i2;
        gate[2 * t] = gate_g * w1; gate[2 * t + 1] = gate_g * w2;
        const unsigned p1 = atomicAdd(cnt + x1, 1u); list[(size_t)x1 * LIST_CAP + p1] = 2 * t;
        const unsigned p2 = atomicAdd(cnt + x2, 1u); list[(size_t)x2 * LIST_CAP + p2] = 2 * t + 1;
    }
}
__global__ void k_offsets(const unsigned* cnt, unsigned* off) { if (threadIdx.x == 0 && blockIdx.x == 0) { unsigned a = 0; for (int e = 0; e < NEXP; ++e) { off[e] = a; a += (cnt[e] + 255u) / 256u * 256u; } off[NEXP] = a; } }

namespace pg8 {
#define PG8_LAS __attribute__((address_space(3)))
typedef unsigned short bf16_t;
typedef short bf16x8 __attribute__((ext_vector_type(8)));
typedef float f32x4 __attribute__((ext_vector_type(4)));
typedef float f32x2 __attribute__((ext_vector_type(2)));
typedef unsigned u32x4 __attribute__((ext_vector_type(4)));
typedef unsigned u32x2 __attribute__((ext_vector_type(2)));
constexpr int BM = 256, BK = 64, HALF = 128, HTB = HALF * BK * 2  , STAGE_BYTES = 8 * HTB, NXCD = 8, WGM = 8;

__host__ __device__ __forceinline__ int lds_byte(int r, int c) { const int st = (r >> 4) * 2 + (c >> 5), rr = r & 15, cc = c & 31, ob = rr * 64 + cc * 2; return st * 1024 + (ob ^ (((ob >> 9) & 1) << 5)); }
__host__ __device__ __forceinline__ void stage_rc(int b, int& R, int& C) { const int st = b / 1024, sb = b % 1024, swz = sb ^ (((sb >> 9) & 1) << 5); R = (st >> 1) * 16 + swz / 64; C = (st & 1) * 32 + (swz % 64) / 2; }
__host__ __device__ __forceinline__ int perm32(int rho) { const int n = rho >> 4, i = rho & 15; return 8 * (i >> 2) + 4 * n + (i & 3); }

struct Unit { int pm, pn, e, rows; };
struct Gemm { const bf16_t* A; const bf16_t* Bt; int lda, ldb, K; };

struct DenseOrder {
    static constexpr bool GATHER = false;
    int nM, nN, nwg, G, c, lda, ldb;
    __device__ void init(int M, int N, int G_, int c_, int lda_, int ldb_) { nM = M / BM; nN = N / BM; nwg = nM * nN; G = G_; c = c_; lda = lda_; ldb = ldb_; }
    __device__ bool next(int i, Unit& u) const {
        const long L = (long)i * G + c; if (L >= nwg) return false;
        int wgid = (int)L; { const int q = nwg / NXCD, r = nwg % NXCD, xcd = wgid % NXCD, off = wgid / NXCD; wgid = (xcd < r ? xcd * (q + 1) : r * (q + 1) + (xcd - r) * q) + off; }
        const int nig = WGM * nN, gid = wgid / nig, fm = gid * WGM, gsz = (nM - fm) < WGM ? (nM - fm) : WGM;
        u.pm = fm + ((wgid % nig) % gsz); u.pn = (wgid % nig) / gsz; u.e = 0; u.rows = BM; return true;
    }
    __device__ size_t a_off(const Unit& u) const { return (size_t)u.pm * BM * lda * 2; }
    __device__ size_t b_off(const Unit& u) const { return (size_t)u.pn * BM * ldb * 2; }
    __device__ int a_row(const Unit&, int) const { return 0; }
};

__device__ __forceinline__ unsigned cvt_pk_bf16(float lo, float hi) { unsigned r; asm volatile("v_cvt_pk_bf16_f32 %0, %1, %2" : "=v"(r) : "v"(lo), "v"(hi)); return r; }

template <class Epi, class Sched, bool ALIGN_EPI>
__device__ __forceinline__ void gemm_phase(PG8_LAS unsigned char* lds, const Gemm g, const Sched& S, const Epi& E) {
    int tid_ = threadIdx.x; asm volatile("" : "+v"(tid_));
    const int tid = tid_, wid = __builtin_amdgcn_readfirstlane(tid >> 6), lane = tid & 63, wr = wid >> 2, wc = wid & 3, fr = lane & 15, fq = lane >> 4;
    const int K = g.K, nt = K / BK;
    constexpr int NVA = Sched::GATHER ? 2 : 1;
    unsigned voffA[NVA][2], voffB[2];
#pragma unroll
    for (int i = 0; i < 2; ++i) { int R, C; stage_rc(tid * 16 + i * 8192, R, C); const int Rb = Epi::PERM ? ((R & ~31) + perm32(R & 31)) : R;
        voffA[0][i] = (unsigned)(R * g.lda + C) * 2u; voffB[i] = (unsigned)(Rb * g.ldb + C) * 2u; }
    const size_t kstep = (size_t)(BK * 2);
    const size_t hstepB = (size_t)HALF * g.ldb * 2;
    const size_t hstepA = Sched::GATHER ? (size_t)0 : (size_t)HALF * g.lda * 2;
#define PG8_VA1 voffA[NVA - 1]
#define PG8_GATHER_OFFS(dst, unit) do { int _t = tid; asm volatile("" : "+v"(_t)); _Pragma("unroll") for (int _h = 0; _h < 2; ++_h) _Pragma("unroll") for (int _i = 0; _i < 2; ++_i) { int _R, _C; stage_rc(_t * 16 + _i * 8192, _R, _C); \
        dst[_h][_i] = (unsigned)(S.a_row(unit, _R + _h * HALF) * g.lda + _C) * 2u; } } while (0)
    const unsigned ldsw = (unsigned)wid * 1024u;
    const int aoff = lds_byte(wr * 64 + fr, fq * 8), boff = lds_byte(wc * 32 + fr, fq * 8);
#define PG8_SA(b, h) (((b) * 2 + (h)) * HTB)
#define PG8_SB(b, h) ((4 + (b) * 2 + (h)) * HTB)
#define PG8_STAGE(bufoff, gbase, voff) do { _Pragma("unroll") for (int _i = 0; _i < 2; ++_i) \
        __builtin_amdgcn_global_load_lds((const unsigned*)((const char*)(gbase) + (voff)[_i]), (PG8_LAS unsigned*)(lds + (bufoff) + ldsw + _i * 8192), 16, 0, 0); } while (0)
#define PG8_LDA(dst, b, h) do { _Pragma("unroll") for (int m = 0; m < 4; ++m) _Pragma("unroll") for (int k = 0; k < 2; ++k) dst[m][k] = *(const PG8_LAS bf16x8*)(lds + PG8_SA(b, h) + aoff + m * 2048 + k * 1024); } while (0)
#define PG8_LDB(dst, b, h) do { _Pragma("unroll") for (int n = 0; n < 2; ++n) _Pragma("unroll") for (int k = 0; k < 2; ++k) dst[n][k] = *(const PG8_LAS bf16x8*)(lds + PG8_SB(b, h) + boff + n * 2048 + k * 1024); } while (0)
#define PG8_MMA(ai, bj, At, Bt) do { __builtin_amdgcn_s_setprio(1); _Pragma("unroll") for (int m = 0; m < 4; ++m) _Pragma("unroll") for (int n = 0; n < 2; ++n) _Pragma("unroll") for (int k = 0; k < 2; ++k) \
        acc[ai][bj][m][n] = __builtin_amdgcn_mfma_f32_16x16x32_bf16(Bt[n][k], At[m][k], acc[ai][bj][m][n], 0, 0, 0); __builtin_amdgcn_s_setprio(0); } while (0)
#define PG8_WAIT_V(n) asm volatile("s_waitcnt vmcnt(" #n ")" ::: "memory")
#define PG8_WAIT_L(n) asm volatile("s_waitcnt lgkmcnt(" #n ")" ::: "memory")
#define PG8_BAR __builtin_amdgcn_s_barrier()
#define PG8_SCHED __builtin_amdgcn_sched_barrier(0)
    Unit cur, nxt; int ui = 0;
    if (!S.next(0, cur)) return;
    f32x4 acc[2][2][4][2];
#pragma unroll
    for (int a = 0; a < 2; ++a)
#pragma unroll
        for (int b = 0; b < 2; ++b)
#pragma unroll
            for (int m = 0; m < 4; ++m)
#pragma unroll
                for (int n = 0; n < 2; ++n) acc[a][b][m][n] = (f32x4){0.f, 0.f, 0.f, 0.f};
    bf16x8 At[4][2], B0[2][2], B1[2][2];
    const char* cA = (const char*)g.A + S.a_off(cur); const char* cB = (const char*)g.Bt + S.b_off(cur);
    if constexpr (Sched::GATHER) { PG8_GATHER_OFFS(voffA, cur); }
    PG8_STAGE(PG8_SB(0, 0), cB, voffB); PG8_STAGE(PG8_SB(0, 1), cB + hstepB, voffB); PG8_STAGE(PG8_SA(0, 0), cA, voffA[0]); PG8_STAGE(PG8_SA(0, 1), cA + hstepA, PG8_VA1);
    if (wr == 1) PG8_BAR;
    PG8_WAIT_V(2); PG8_BAR;
    PG8_STAGE(PG8_SB(1, 0), cB + kstep, voffB); PG8_STAGE(PG8_SA(1, 0), cA + kstep, voffA[0]); PG8_STAGE(PG8_SB(1, 1), cB + hstepB + kstep, voffB);
    PG8_WAIT_V(6); PG8_BAR;
    for (;;) {
        const bool has_next = S.next(ui + 1, nxt);
        const char* nA = has_next ? (const char*)g.A + S.a_off(nxt) : cA; const char* nB = has_next ? (const char*)g.Bt + S.b_off(nxt) : cB;
        for (int t = 0; t < nt; t += 2) {
            const bool last = (t == nt - 2);
            const char* a1 = cA + (size_t)(t + 1) * kstep;
            const char* a2 = last ? nA : cA + (size_t)(t + 2) * kstep; const char* b2 = last ? nB : cB + (size_t)(t + 2) * kstep;
            const char* a3 = a2 + kstep; const char* b3 = b2 + kstep;
            unsigned nvo[2][2];
            if constexpr (Sched::GATHER) { if (last && has_next) { PG8_GATHER_OFFS(nvo, nxt); } }
            PG8_LDB(B0, 0, 0); PG8_LDB(B1, 0, 1); PG8_SCHED; PG8_LDA(At, 0, 0); PG8_STAGE(PG8_SA(1, 1), a1 + hstepA, PG8_VA1);
            PG8_WAIT_V(8); PG8_WAIT_L(0); PG8_BAR; PG8_MMA(0, 0, At, B0); PG8_MMA(0, 1, At, B1); PG8_BAR; PG8_SCHED;
            if constexpr (Sched::GATHER) { if (last && has_next) {
#pragma unroll
                for (int h = 0; h < NVA; ++h)
#pragma unroll
                    for (int i = 0; i < 2; ++i) voffA[h][i] = nvo[h][i]; } }
            PG8_LDA(At, 0, 1); PG8_STAGE(PG8_SB(0, 0), b2, voffB); PG8_STAGE(PG8_SB(0, 1), b2 + hstepB, voffB); PG8_STAGE(PG8_SA(0, 0), a2, voffA[0]);
            PG8_WAIT_V(8); PG8_WAIT_L(0); PG8_BAR; PG8_MMA(1, 0, At, B0); PG8_MMA(1, 1, At, B1); PG8_BAR; PG8_SCHED;
            PG8_LDB(B0, 1, 0); PG8_LDB(B1, 1, 1); PG8_SCHED; PG8_LDA(At, 1, 0); PG8_STAGE(PG8_SA(0, 1), a2 + hstepA, PG8_VA1);
            PG8_WAIT_V(8); PG8_WAIT_L(0); PG8_BAR; PG8_MMA(0, 0, At, B0); PG8_MMA(0, 1, At, B1); PG8_BAR; PG8_SCHED;
            PG8_LDA(At, 1, 1); PG8_STAGE(PG8_SB(1, 0), b3, voffB); PG8_STAGE(PG8_SB(1, 1), b3 + hstepB, voffB); PG8_STAGE(PG8_SA(1, 0), a3, voffA[0]);
            PG8_WAIT_V(8); PG8_WAIT_L(0); PG8_BAR; PG8_MMA(1, 0, At, B0); PG8_MMA(1, 1, At, B1); PG8_BAR; PG8_SCHED;
        }
        if constexpr (ALIGN_EPI) { if (wr == 0) PG8_BAR; }
        if constexpr (!Epi::AFTER_DRAIN) { E(acc, cur, wr, wc, fr, fq); }
        if (!has_next) break;
#pragma unroll
        for (int a = 0; a < 2; ++a)
#pragma unroll
            for (int b = 0; b < 2; ++b)
#pragma unroll
                for (int m = 0; m < 4; ++m)
#pragma unroll
                    for (int n = 0; n < 2; ++n) acc[a][b][m][n] = (f32x4){0.f, 0.f, 0.f, 0.f};
        cur = nxt; cA = nA; cB = nB; ++ui;
        if constexpr (ALIGN_EPI) { if (wr == 1) PG8_BAR; }
    }
    PG8_WAIT_V(0);
    if constexpr (!ALIGN_EPI) { if (wr == 0) PG8_BAR; }
    PG8_BAR;
    if constexpr (Epi::AFTER_DRAIN) { E.fused(acc, cur, wr, wc, fr, fq, lds, wid, lane); }
#undef PG8_SA
#undef PG8_VA1
#undef PG8_GATHER_OFFS
#undef PG8_SB
#undef PG8_STAGE
#undef PG8_LDA
#undef PG8_LDB
#undef PG8_MMA
#undef PG8_WAIT_V
#undef PG8_WAIT_L
#undef PG8_BAR
#undef PG8_SCHED
}
}
namespace pg8 {
__device__ __forceinline__ float gelu_tanh_f(float x) {
    const float u = x * (0.7978845608028654f + 0.035677408136300125f * x * x);
    const float e = __builtin_amdgcn_exp2f(-2.8853900817779268f * u);
    return x * __builtin_amdgcn_rcpf(1.0f + e);
}
__device__ __forceinline__ float silu_f(float x) { return x * __builtin_amdgcn_rcpf(1.0f + __builtin_amdgcn_exp2f(-1.4426950408889634f * x)); }

struct EpiResid {
    static constexpr bool PERM = false, AFTER_DRAIN = false;
    const float* X; float* Y; int ldc; float alpha;
    __device__ __forceinline__ void operator()(const f32x4 (&acc)[2][2][4][2], const Unit& u, int wr, int wc, int fr, int fq) const {
        const int row0 = u.pm * BM + wr * 64 + fr, col0 = u.pn * BM + wc * 32 + 4 * fq;
#pragma unroll
        for (int ai = 0; ai < 2; ++ai)
#pragma unroll
            for (int m = 0; m < 4; ++m) { const size_t off = (size_t)(row0 + ai * HALF + m * 16) * ldc + col0;
#pragma unroll
                for (int bj = 0; bj < 2; ++bj)
#pragma unroll
                    for (int n = 0; n < 2; ++n) { const f32x4 xv = *(const f32x4*)(X + off + bj * HALF + n * 16); *(f32x4*)(Y + off + bj * HALF + n * 16) = xv * alpha + acc[ai][bj][m][n]; }
                asm volatile("" ::: "memory"); }
    }
};
struct EpiBf16 {
    static constexpr bool PERM = true, AFTER_DRAIN = false;
    bf16_t* O; int ldc; int gelu_from;
    __device__ __forceinline__ void operator()(const f32x4 (&acc)[2][2][4][2], const Unit& u, int wr, int wc, int fr, int fq) const {
        const int row0 = u.pm * BM + wr * 64 + fr, col0 = u.pn * BM + wc * 32 + 8 * fq;
        const bool act = u.pn >= gelu_from;
#pragma unroll
        for (int ai = 0; ai < 2; ++ai)
#pragma unroll
            for (int m = 0; m < 4; ++m) { bf16_t* rowp = O + (size_t)(row0 + ai * HALF + m * 16) * ldc + col0;
#pragma unroll
                for (int bj = 0; bj < 2; ++bj) { f32x4 v0 = acc[ai][bj][m][0], v1 = acc[ai][bj][m][1];
                    if (act) {
#pragma unroll
                        for (int j = 0; j < 4; ++j) { v0[j] = gelu_tanh_f(v0[j]); v1[j] = gelu_tanh_f(v1[j]); } }
                    u32x4 w; w.x = cvt_pk_bf16(v0[0], v0[1]); w.y = cvt_pk_bf16(v0[2], v0[3]); w.z = cvt_pk_bf16(v1[0], v1[1]); w.w = cvt_pk_bf16(v1[2], v1[3]);
                    *(u32x4*)(rowp + bj * HALF) = w; } }
    }
};
template <int MODE> struct EpiPair {
    static constexpr bool PERM = true, AFTER_DRAIN = false;
    bf16_t* O; bf16_t* O2; int ldc, npair, ldc2;
    __device__ __forceinline__ void operator()(const f32x4 (&acc)[2][2][4][2], const Unit& u, int wr, int wc, int fr, int fq) const {
        const int row0 = u.pm * BM + wr * 64 + fr;
        if (u.pn < npair) {
            const int col0 = u.pn * HALF + wc * 32 + 8 * fq;
#pragma unroll
            for (int ai = 0; ai < 2; ++ai)
#pragma unroll
                for (int m = 0; m < 4; ++m) { bf16_t* rowp = O + (size_t)(row0 + ai * HALF + m * 16) * ldc + col0;
                    f32x4 v0, v1;
#pragma unroll
                    for (int j = 0; j < 4; ++j) { const float a0 = acc[ai][0][m][0][j], a1 = acc[ai][0][m][1][j];
                        v0[j] = (MODE == 1 ? silu_f(a0) : a0) * acc[ai][1][m][0][j]; v1[j] = (MODE == 1 ? silu_f(a1) : a1) * acc[ai][1][m][1][j]; }
                    u32x4 w; w.x = cvt_pk_bf16(v0[0], v0[1]); w.y = cvt_pk_bf16(v0[2], v0[3]); w.z = cvt_pk_bf16(v1[0], v1[1]); w.w = cvt_pk_bf16(v1[2], v1[3]);
                    *(u32x4*)rowp = w; }
        } else {
            const int col0 = (u.pn - npair) * BM + wc * 32 + 8 * fq;
#pragma unroll
            for (int ai = 0; ai < 2; ++ai)
#pragma unroll
                for (int m = 0; m < 4; ++m) { bf16_t* rowp = O2 + (size_t)(row0 + ai * HALF + m * 16) * ldc2 + col0;
#pragma unroll
                    for (int bj = 0; bj < 2; ++bj) { const f32x4 v0 = acc[ai][bj][m][0], v1 = acc[ai][bj][m][1];
                        u32x4 w; w.x = cvt_pk_bf16(v0[0], v0[1]); w.y = cvt_pk_bf16(v0[2], v0[3]); w.z = cvt_pk_bf16(v1[0], v1[1]); w.w = cvt_pk_bf16(v1[2], v1[3]);
                        *(u32x4*)(rowp + bj * HALF) = w; } }
        }
    }
};
struct EpiMoe1 {
    static constexpr bool PERM = true, AFTER_DRAIN = false;
    bf16_t* HID; const PG8_LAS int* tab;
    __device__ __forceinline__ void operator()(const f32x4 (&acc)[2][2][4][2], const Unit& u, int wr, int wc, int fr, int fq) const {
        const int row0 = (tab[u.e] + u.pm) * BM + wr * 64 + fr, col0 = u.pn * HALF + wc * 32 + 8 * fq;
#pragma unroll
        for (int ai = 0; ai < 2; ++ai)
#pragma unroll
            for (int m = 0; m < 4; ++m) { bf16_t* rowp = HID + (size_t)(row0 + ai * HALF + m * 16) * 512 + col0;
                f32x4 v0, v1;
#pragma unroll
                for (int j = 0; j < 4; ++j) { v0[j] = silu_f(acc[ai][0][m][0][j]) * acc[ai][1][m][0][j]; v1[j] = silu_f(acc[ai][0][m][1][j]) * acc[ai][1][m][1][j]; }
                u32x4 w; w.x = cvt_pk_bf16(v0[0], v0[1]); w.y = cvt_pk_bf16(v0[2], v0[3]); w.z = cvt_pk_bf16(v1[0], v1[1]); w.w = cvt_pk_bf16(v1[2], v1[3]);
                *(u32x4*)rowp = w; }
    }
};
struct EpiMoe2 {
    static constexpr bool PERM = true, AFTER_DRAIN = false;
    bf16_t* OUT2; const int* list; const float* gate; int cap;
    __device__ __forceinline__ void operator()(const f32x4 (&acc)[2][2][4][2], const Unit& u, int wr, int wc, int fr, int fq) const {
        const int r0 = wr * 64 + fr, col0 = u.pn * BM + wc * 32 + 8 * fq;
        const int* lp = list + (size_t)u.e * cap + u.pm * BM;
#pragma unroll
        for (int ai = 0; ai < 2; ++ai)
#pragma unroll
            for (int m = 0; m < 4; ++m) { const int r = r0 + ai * HALF + m * 16;
                if (r < u.rows) { const int slot = lp[r]; const float gt = gate[slot]; bf16_t* rowp = OUT2 + (size_t)slot * 1024 + col0;
#pragma unroll
                    for (int bj = 0; bj < 2; ++bj) { const f32x4 v0 = acc[ai][bj][m][0] * gt, v1 = acc[ai][bj][m][1] * gt;
                        u32x4 w; w.x = cvt_pk_bf16(v0[0], v0[1]); w.y = cvt_pk_bf16(v0[2], v0[3]); w.z = cvt_pk_bf16(v1[0], v1[1]); w.w = cvt_pk_bf16(v1[2], v1[3]);
                        *(u32x4*)(rowp + bj * HALF) = w; } } }
    }
};
struct EpiSoftmax {
    static constexpr bool PERM = true, AFTER_DRAIN = true;
    bf16_t* P; int ldc; float scale_log2e;
    __device__ __forceinline__ void fused(f32x4 (&acc)[2][2][4][2], const Unit& u, int wr, int wc, int fr, int fq, PG8_LAS unsigned char* lds, int wid, int lane) const {
        PG8_LAS float* PM = (PG8_LAS float*)lds;
        PG8_LAS float* PS = (PG8_LAS float*)(lds + 4096);
#pragma unroll
        for (int ai = 0; ai < 2; ++ai)
#pragma unroll
            for (int m = 0; m < 4; ++m) { float mx = -3.0e38f;
#pragma unroll
                for (int bj = 0; bj < 2; ++bj)
#pragma unroll
                    for (int n = 0; n < 2; ++n) { const f32x4 x = acc[ai][bj][m][n]; mx = fmaxf(mx, fmaxf(fmaxf(x[0], x[1]), fmaxf(x[2], x[3]))); }
                mx = fmaxf(mx, __shfl_xor(mx, 16)); mx = fmaxf(mx, __shfl_xor(mx, 32));
                if (fq == 0) PM[(ai * HALF + wr * 64 + m * 16 + fr) * 4 + wc] = mx; }
        asm volatile("s_waitcnt lgkmcnt(0)" ::: "memory"); __builtin_amdgcn_s_barrier(); asm volatile("" ::: "memory");
#pragma unroll
        for (int ai = 0; ai < 2; ++ai)
#pragma unroll
            for (int m = 0; m < 4; ++m) { const int r = ai * HALF + wr * 64 + m * 16 + fr; const f32x4 pm = *(const PG8_LAS f32x4*)(PM + r * 4);
                const float mx = fmaxf(fmaxf(pm[0], pm[1]), fmaxf(pm[2], pm[3])) * scale_log2e; float s = 0.f;
#pragma unroll
                for (int bj = 0; bj < 2; ++bj)
#pragma unroll
                    for (int n = 0; n < 2; ++n) { f32x4 x = acc[ai][bj][m][n];
#pragma unroll
                        for (int j = 0; j < 4; ++j) { x[j] = __builtin_amdgcn_exp2f(x[j] * scale_log2e - mx); s += x[j]; }
                        acc[ai][bj][m][n] = x; }
                s += __shfl_xor(s, 16); s += __shfl_xor(s, 32);
                if (fq == 0) PS[r * 4 + wc] = s; }
        asm volatile("s_waitcnt lgkmcnt(0)" ::: "memory"); __builtin_amdgcn_s_barrier(); asm volatile("" ::: "memory");
        const int row0 = u.pm * BM + wr * 64 + fr, col0 = u.pn * BM + wc * 32 + 8 * fq;
#pragma unroll
        for (int ai = 0; ai < 2; ++ai)
#pragma unroll
            for (int m = 0; m < 4; ++m) { const int r = ai * HALF + wr * 64 + m * 16 + fr; const f32x4 ps = *(const PG8_LAS f32x4*)(PS + r * 4);
                const float inv = 1.0f / ((ps[0] + ps[1]) + (ps[2] + ps[3])); bf16_t* rowp = P + (size_t)(row0 + ai * HALF + m * 16) * ldc + col0;
#pragma unroll
                for (int bj = 0; bj < 2; ++bj) { const f32x4 v0 = acc[ai][bj][m][0] * inv, v1 = acc[ai][bj][m][1] * inv;
                    u32x4 w; w.x = cvt_pk_bf16(v0[0], v0[1]); w.y = cvt_pk_bf16(v0[2], v0[3]); w.z = cvt_pk_bf16(v1[0], v1[1]); w.w = cvt_pk_bf16(v1[2], v1[3]);
                    *(u32x4*)(rowp + bj * HALF) = w; } }
    }
};
}
constexpr int NWAVES = 8;
constexpr int NPL = 12;
constexpr int NPHASE = 2 + DEPTH * NPL;
constexpr size_t WS_W_EIN = WS_END;
constexpr size_t WS_W_EOUT = WS_W_EIN + 6 * MiB;
constexpr size_t WS_W_OIN = WS_W_EOUT + 4 * MiB;
constexpr size_t WS_W_OOUT = WS_W_OIN + 12 * MiB;
constexpr size_t WS_WSB = WS_W_OOUT + 4 * MiB;
constexpr size_t WS_WQ = WS_WSB + 1 * MiB;
constexpr size_t WS_WO = WS_WQ + 8 * MiB;
constexpr size_t WS_WK = WS_WO + 8 * MiB;
constexpr size_t WS_WV = WS_WK + 8 * MiB;
constexpr size_t WS_W13 = WS_WV + 8 * MiB;
constexpr size_t WS_W2 = WS_W13 + 256 * MiB;
constexpr size_t WS_END2 = WS_W2 + 128 * MiB;
constexpr int CW_BAR = 8192;
constexpr int RING_BYTES = 131072, LDSCTL_OFF = RING_BYTES, MISC_OFF = LDSCTL_OFF + 320, TAB_OFF = LDSCTL_OFF + 1024;
constexpr int LDS_BYTES = 147456;

#define GAS __attribute__((address_space(1)))
#define LAS __attribute__((address_space(3)))
typedef unsigned v4u __attribute__((ext_vector_type(4)));
typedef unsigned v2u __attribute__((ext_vector_type(2)));
typedef float f32x4 __attribute__((ext_vector_type(4)));
typedef short bf16x8v __attribute__((ext_vector_type(8)));
#define LDS_WAIT() asm volatile("s_waitcnt lgkmcnt(0)" ::: "memory")
#define VM_WAIT() asm volatile("s_waitcnt vmcnt(0)" ::: "memory")
__device__ __forceinline__ unsigned pk2(float lo, float hi) { return f2bf(lo) | (f2bf(hi) << 16); }
__device__ __forceinline__ float bflo(unsigned w) { return __builtin_bit_cast(float, w << 16); }
__device__ __forceinline__ float bfhi(unsigned w) { return __builtin_bit_cast(float, w & 0xffff0000u); }

#define XB_TMO      128
#define XB_XCNT(j)  (256  + 64 * (j))
#define XB_XSUB(j)  (1280 + 64 * (j))
#define XB_XGEN(j)  (2304 + 64 * (j))
#define XB_TOP      3328
#define XB_TOPGEN   3392
#define XCD_BAR_WORDS 3456
#define XB_SPIN_CAP (1u << 18)

__device__ __forceinline__ unsigned xb_ld(unsigned* p)              { return __hip_atomic_load(p, __ATOMIC_RELAXED, __HIP_MEMORY_SCOPE_AGENT); }
__device__ __forceinline__ unsigned xb_add(unsigned* p, unsigned v) { return __hip_atomic_fetch_add(p, v, __ATOMIC_RELAXED, __HIP_MEMORY_SCOPE_AGENT); }
__device__ __forceinline__ unsigned xb_xcc_id() { return (unsigned)__builtin_amdgcn_s_getreg((3 << 11) | 20) & 0xFu; }
#define XB_SPIN(cond, bar) do { unsigned _sp = 0; while (cond) { __builtin_amdgcn_s_sleep(1); \
    if ((++_sp & 255u) == 0u) { if (xb_ld(&(bar)[XB_TMO])) break; if (_sp > XB_SPIN_CAP) { atomicAdd(&(bar)[XB_TMO], 1u); break; } } } } while (0)

struct XcdBarrier {
    unsigned* bar; unsigned x;
    volatile LAS unsigned* st;
};

__device__ __forceinline__ XcdBarrier xcd_barrier_post(unsigned* bar, volatile LAS unsigned* st) {
    XcdBarrier b; b.bar = bar; b.x = xb_xcc_id(); b.st = st;
    if (threadIdx.x == 0) (void)xb_add(&bar[XB_XCNT(b.x)], 1u);
    return b;
}
__device__ __forceinline__ void xcd_barrier_complete(unsigned* bar, unsigned x, unsigned& nloc, unsigned& nx) {
    const unsigned G = gridDim.x * gridDim.y * gridDim.z;
    unsigned sum, cnt, mine, sp = 0u;
    for (;;) {
        sum = 0u; cnt = 0u; mine = 0u;
#pragma unroll
        for (unsigned j = 0; j < 16; ++j) { const unsigned c = xb_ld(&bar[XB_XCNT(j)]); sum += c; cnt += (c > 0u) ? 1u : 0u; mine = (j == x) ? c : mine; }
        if (sum == G) break;
        __builtin_amdgcn_s_sleep(1);
        if ((++sp & 255u) == 0u) { if (xb_ld(&bar[XB_TMO])) break; if (sp > XB_SPIN_CAP) { atomicAdd(&bar[XB_TMO], 1u); break; } }
    }
    nloc = mine > 0u ? mine : 1u; nx = cnt > 0u ? cnt : 1u;
}

__device__ __forceinline__ void xcd_barrier(const XcdBarrier& b) {
    asm volatile("s_waitcnt vmcnt(0)" ::: "memory");
    __syncthreads();
    if (threadIdx.x == 0) {
        unsigned* bar = b.bar;
        __builtin_amdgcn_s_waitcnt(0);
        unsigned nloc = b.st[0], nx = b.st[1];
        if (nloc == 0u) { xcd_barrier_complete(bar, b.x, nloc, nx); b.st[0] = nloc; b.st[1] = nx; }
        const unsigned old = xb_add(&bar[XB_XSUB(b.x)], 1u);
        const unsigned gen = old / nloc;
        if (old + 1u == (gen + 1u) * nloc) {
            __builtin_amdgcn_fence(__ATOMIC_RELEASE, "agent");
            asm volatile("s_waitcnt vmcnt(0)" ::: "memory");
            const unsigned og = xb_add(&bar[XB_TOP], 1u);
            const unsigned tg = og / nx;
            if (og + 1u == (tg + 1u) * nx) xb_add(&bar[XB_TOPGEN], 1u);
            else XB_SPIN(xb_ld(&bar[XB_TOPGEN]) == tg, bar);
            __builtin_amdgcn_fence(__ATOMIC_ACQUIRE, "agent");
            xb_add(&bar[XB_XGEN(b.x)], 1u);
            asm volatile("s_waitcnt vmcnt(0)" ::: "memory");
        } else {
            XB_SPIN(xb_ld(&bar[XB_XGEN(b.x)]) == gen, bar);
            __builtin_amdgcn_fence(__ATOMIC_ACQUIRE, "agent");
            asm volatile("s_waitcnt vmcnt(0)" ::: "memory");
        }
    }
    __syncthreads();
}


struct Args { const float* in[27]; float* out; unsigned char* ws; int ph_lo, ph_hi; };

struct Frame {
    LAS unsigned char* lds;
    int tid, lane, wave, vcu, G;
    unsigned char* ws;
};
__device__ __forceinline__ void frame_refresh(Frame& F) { int t = threadIdx.x; asm volatile("" : "+v"(t)); F.tid = t; F.lane = t & 63; F.wave = __builtin_amdgcn_readfirstlane(t >> 6); }

struct AttnOrder {
    static constexpr bool GATHER = false;
    int G, c, l, mode;
    __device__ bool next(int i, pg8::Unit& u) const {
        const int L = i * G + c; if (L >= 256) return false;
        const int xcd = L & 7, j = L >> 3, b = xcd >> 1, idx = (xcd & 1) * 32 + j;
        u.pm = b * 16 + (idx >> 2); u.pn = idx & 3; u.e = b; u.rows = 256; return true;
    }
    __device__ size_t a_off(const pg8::Unit& u) const { return ((size_t)u.pm * 256 * DM + (size_t)u.pn * XHD) * 2; }
    __device__ size_t b_off(const pg8::Unit& u) const {
        return mode == 0 ? ((size_t)(u.e * MEM) * (DEPTH * DM) + (size_t)l * DM + (size_t)u.pn * XHD) * 2
                         : ((size_t)(l * DM + u.pn * XHD) * NMEM + (size_t)u.e * MEM) * 2; }
    __device__ int a_row(const pg8::Unit&, int) const { return 0; }
};
template <bool GATHER_> struct MoeOrder {
    static constexpr bool GATHER = GATHER_;
    int G, c, NT; const LAS int* tab; const LAS int* cnt; const int* list; size_t bstride_e; int ldb;
    __device__ bool next(int i, pg8::Unit& u) const {
        const int L = i * G + c; const int total = __builtin_amdgcn_readfirstlane(tab[NEXP]) * NT; if (L >= total) return false;
        const int T = L / NT; int e = 0;
        for (int k = 1; k < NEXP; ++k) { if (__builtin_amdgcn_readfirstlane(tab[k]) <= T) e = k; }
        u.e = e; u.pm = T - __builtin_amdgcn_readfirstlane(tab[e]); u.pn = L - T * NT;
        const int left = __builtin_amdgcn_readfirstlane(cnt[e]) - u.pm * 256; u.rows = left < 256 ? left : 256; return true;
    }
    __device__ size_t a_off(const pg8::Unit& u) const { return GATHER ? (size_t)0 : (size_t)(tab[u.e] + u.pm) * 256 * DEXP * 2; }
    __device__ size_t b_off(const pg8::Unit& u) const { return (size_t)u.e * bstride_e + (size_t)u.pn * 256 * ldb * 2; }
    __device__ int a_row(const pg8::Unit& u, int r) const { const int rr = r < u.rows ? r : u.rows - 1; return list[(size_t)u.e * LIST_CAP + u.pm * 256 + rr] >> 1; }
};
__device__ __forceinline__ void moe_tables(Frame& F, const unsigned* cntg) {
    frame_refresh(F);
    LAS int* tab = (LAS int*)(F.lds + TAB_OFF); LAS int* cl = tab + 40;
    if (F.tid < 64) { const int c = F.tid < NEXP ? (int)cntg[F.tid] : 0; int tl = (c + 255) >> 8; int inc = tl;
#pragma unroll
        for (int o = 1; o < 32; o <<= 1) { const int t = __shfl_up(inc, o); if (F.lane >= o) inc += t; }
        if (F.tid < NEXP) { tab[F.tid] = inc - tl; cl[F.tid] = c; } if (F.tid == NEXP - 1) tab[NEXP] = inc; }
    LDS_WAIT(); __syncthreads();
}

__device__ __forceinline__ void tr_store(LAS float* scr, bf16* dst, int ldd, int drow0, int k0, int lane) {
    LDS_WAIT(); asm volatile("" ::: "memory");
    const int c = lane & 7;
#pragma unroll
    for (int j = 0; j < 4; ++j) { const int n = (lane >> 3) + 8 * j; const LAS float* s = scr + (8 * c) * 33 + n;
        v4u o; o.x = pk2(s[0 * 33], s[1 * 33]); o.y = pk2(s[2 * 33], s[3 * 33]); o.z = pk2(s[4 * 33], s[5 * 33]); o.w = pk2(s[6 * 33], s[7 * 33]);
        *(GAS v4u*)(dst + (size_t)(drow0 + n) * ldd + k0 + 8 * c) = o; }
    LDS_WAIT(); asm volatile("" ::: "memory");
}
__device__ __forceinline__ void tr_item(const float* src, int lds_, int k0, int n0, bf16* dst, int ldd, int drow0, LAS float* scr, int lane) {
    float v[32];
#pragma unroll
    for (int i = 0; i < 32; ++i) { const int kk = 2 * i + (lane >> 5); v[i] = src[(size_t)(k0 + kk) * lds_ + n0 + (lane & 31)]; }
#pragma unroll
    for (int i = 0; i < 32; ++i) { const int kk = 2 * i + (lane >> 5); scr[kk * 33 + (lane & 31)] = v[i]; }
    tr_store(scr, dst, ldd, drow0, k0, lane);
}
__device__ __forceinline__ void fold_item(const float* w_in, const float* w_pool, const float* scale, int k0, int n0, bf16* dst, LAS float* scr, int lane) {
    const int g = n0 >> 7, nn = (n0 & 127) + (lane & 31), kh = lane >> 5;
    float acc[32];
#pragma unroll
    for (int j = 0; j < 32; ++j) acc[j] = 0.f;
    const float* wp = w_pool + (size_t)g * 128 * 128 + nn;
    const float* wi = w_in + (size_t)(k0 + kh) * DIN_E + g * 128;
    for (int c = 0; c < 128; ++c) { const float p = wp[(size_t)c * 128];
#pragma unroll
        for (int j = 0; j < 32; ++j) acc[j] += wi[(size_t)(2 * j) * DIN_E + c] * p; }
    const float sc = scale[n0 + (lane & 31)];
#pragma unroll
    for (int j = 0; j < 32; ++j) scr[(2 * j + kh) * 33 + (lane & 31)] = acc[j] * sc;
    tr_store(scr, dst, DM, n0, k0, lane);
}
__device__ __forceinline__ void cvt_rows(const float* src, bf16* dst, size_t n8, size_t gtid, size_t nthr) {
    for (size_t i = gtid; i < n8; i += nthr) { const f32x4 a = *(const GAS f32x4*)(src + i * 8), b = *(const GAS f32x4*)(src + i * 8 + 4);
        v4u o; o.x = pk2(a.x, a.y); o.y = pk2(a.z, a.w); o.z = pk2(b.x, b.y); o.w = pk2(b.z, b.w); *(GAS v4u*)(dst + i * 8) = o; }
}
__device__ __forceinline__ void prep_phase(Frame& F, const Args& A) {
    frame_refresh(F);
    LAS float* scr = (LAS float*)(F.lds + F.wave * 16384);
    const int gw = F.vcu * NWAVES + F.wave, NGW = F.G * NWAVES, lane = F.lane;
    bf16* W13 = (bf16*)(F.ws + WS_W13); bf16* W2T = (bf16*)(F.ws + WS_W2);
    constexpr int I_W1 = DEPTH * NEXP * 256, I_W2 = DEPTH * NEXP * 256, I_SQ = 20 * 512, I_EIN = 2 * 16 * 32, I_OIN = 2 * 16 * 96, I_FOLD = 2 * 256;
    constexpr int NITEMS = 2 * I_W1 + I_W2 + I_SQ + I_EIN + I_OIN + I_FOLD;
    for (int it = gw; it < NITEMS; it += NGW) {
        int r = it;
        if (r < 2 * I_W1) { const int which = r >= I_W1; r -= which * I_W1; const int mat = r >> 8, rem = r & 255, kb = rem >> 4, nb = rem & 15, n0 = nb * 32;
            tr_item((which ? A.in[25] : A.in[24]) + (size_t)mat * DM * DEXP, DEXP, kb * 64, n0, W13 + (size_t)mat * DM * DM, DM, (n0 >> 7) * 256 + which * 128 + (n0 & 127), scr, lane); continue; }
        r -= 2 * I_W1;
        if (r < I_W2) { const int mat = r >> 8, rem = r & 255, kb = rem >> 5, nb = rem & 31;
            tr_item(A.in[26] + (size_t)mat * DEXP * DM, DM, kb * 64, nb * 32, W2T + (size_t)mat * DM * DEXP, DEXP, nb * 32, scr, lane); continue; }
        r -= I_W2;
        if (r < I_SQ) { const int mat = r >> 9, rem = r & 511, kb = rem >> 5, nb = rem & 31; const float* src; bf16* dst;
            if (mat < 2) { src = A.in[9] + (size_t)mat * DM * DM; dst = (bf16*)(F.ws + WS_W_EOUT) + (size_t)mat * DM * DM; }
            else if (mat < 4) { src = A.in[13] + (size_t)(mat - 2) * DM * DM; dst = (bf16*)(F.ws + WS_W_OOUT) + (size_t)(mat - 2) * DM * DM; }
            else if (mat < 8) { src = A.in[14] + (size_t)(mat - 4) * DM * DM; dst = (bf16*)(F.ws + WS_WQ) + (size_t)(mat - 4) * DM * DM; }
            else if (mat < 12) { src = A.in[17] + (size_t)(mat - 8) * DM * DM; dst = (bf16*)(F.ws + WS_WO) + (size_t)(mat - 8) * DM * DM; }
            else if (mat < 16) { src = A.in[15] + (size_t)(mat - 12) * DM * DM; dst = (bf16*)(F.ws + WS_WK) + (size_t)(mat - 12) * DM * DM; }
            else { src = A.in[16] + (size_t)(mat - 16) * DM * DM; dst = (bf16*)(F.ws + WS_WV) + (size_t)(mat - 16) * DM * DM; }
            tr_item(src, DM, kb * 64, nb * 32, dst, DM, nb * 32, scr, lane); continue; }
        r -= I_SQ;
        if (r < I_EIN) { const int i = r >> 9, rem = r & 511, kb = rem >> 5, nb = rem & 31, n0 = 512 + nb * 32;
            tr_item(A.in[2] + (size_t)i * DM * DIN_E, DIN_E, kb * 64, n0, (bf16*)(F.ws + WS_W_EIN) + (size_t)i * DIN_E * DM, DM, n0, scr, lane); continue; }
        r -= I_EIN;
        if (r < I_OIN) { const int i = r / 1536, rem = r % 1536, kb = rem / 96, nb = rem % 96, n0 = nb * 32; int drow;
            if (n0 < DM) drow = 2048 + n0; else if (n0 < 2 * DM) { const int ch = n0 - DM; drow = (ch >> 7) * 256 + (ch & 127); } else { const int ch = n0 - 2 * DM; drow = (ch >> 7) * 256 + 128 + (ch & 127); }
            tr_item(A.in[10] + (size_t)i * DM * DIN_O, DIN_O, kb * 64, n0, (bf16*)(F.ws + WS_W_OIN) + (size_t)i * DIN_O * DM, DM, drow, scr, lane); continue; }
        r -= I_OIN;
        { const int i = r >> 8, rem = r & 255, kb = rem >> 4, nb = rem & 15;
            fold_item(A.in[2] + (size_t)i * DM * DIN_E, A.in[3] + (size_t)i * 4 * 128 * 128, A.in[4] + (size_t)i * 512, kb * 64, nb * 32, (bf16*)(F.ws + WS_W_EIN) + (size_t)i * DIN_E * DM, scr, lane); }
    }
    const size_t gtid = (size_t)F.vcu * (NWAVES * 64) + F.tid, nthr = (size_t)F.G * NWAVES * 64;
    cvt_rows(A.in[0], (bf16*)(F.ws + WS_XB), (size_t)NTOK * DM / 8, gtid, nthr);
    cvt_rows(A.in[1], (bf16*)(F.ws + WS_MEMB), (size_t)NMEM * DM / 8, gtid, nthr);
    bf16* wsb = (bf16*)(F.ws + WS_WSB);
    for (size_t i = gtid; i < (size_t)2 * 4 * 128 * 128; i += nthr) { const int jj = (int)(i & 127), ii = (int)((i >> 7) & 127); wsb[i] = (jj <= ii) ? (bf16)f2bf(A.in[7][i]) : (bf16)0; }
}

__device__ __forceinline__ float wsum(float v) {
#pragma unroll
    for (int o = 1; o < 64; o <<= 1) v += __shfl_xor(v, o);
    return v;
}
template <int MODE, bool ROUTER>
__device__ __forceinline__ void ln_phase(Frame& F, const float* Y, const bf16* OUT2, const float* gam, const float* bet, float* X, bf16* XB, float* OUT,
                                         const float* wrg, const float* brg, const float* wre, const float* bre, unsigned* cnt, int* list, float* gate) {
    frame_refresh(F);
    const int gw = F.vcu * NWAVES + F.wave, NGW = F.G * NWAVES, lane = F.lane;
    f32x4 gv[4], bv[4];
#pragma unroll
    for (int j = 0; j < 4; ++j) { gv[j] = *(const GAS f32x4*)(gam + 4 * lane + 256 * j); bv[j] = *(const GAS f32x4*)(bet + 4 * lane + 256 * j); }
    int myE = 0, mySlot = 0, k = 0;
    for (int row = gw; row < NTOK; row += NGW, ++k) {
        f32x4 v[4]; float s = 0.f;
#pragma unroll
        for (int j = 0; j < 4; ++j) {
            if (MODE == 0) v[j] = *(const GAS f32x4*)(Y + (size_t)row * DM + 4 * lane + 256 * j);
            else { const f32x4 xv = *(const GAS f32x4*)(X + (size_t)row * DM + 4 * lane + 256 * j);
                const v2u a = *(const GAS v2u*)(OUT2 + (size_t)(2 * row) * DM + 4 * lane + 256 * j), b = *(const GAS v2u*)(OUT2 + (size_t)(2 * row + 1) * DM + 4 * lane + 256 * j);
                v[j].x = ALPHA * xv.x + bflo(a.x) + bflo(b.x); v[j].y = ALPHA * xv.y + bfhi(a.x) + bfhi(b.x); v[j].z = ALPHA * xv.z + bflo(a.y) + bflo(b.y); v[j].w = ALPHA * xv.w + bfhi(a.y) + bfhi(b.y); }
            s += (v[j].x + v[j].y) + (v[j].z + v[j].w); }
        const float mean = wsum(s) * (1.f / DM); float s2 = 0.f;
#pragma unroll
        for (int j = 0; j < 4; ++j) { v[j] = v[j] - mean; s2 += (v[j].x * v[j].x + v[j].y * v[j].y) + (v[j].z * v[j].z + v[j].w * v[j].w); }
        const float rstd = 1.f / sqrtf(wsum(s2) * (1.f / DM) + LN_EPS);
#pragma unroll
        for (int j = 0; j < 4; ++j) { v[j] = v[j] * rstd * gv[j] + bv[j];
            *(GAS f32x4*)(X + (size_t)row * DM + 4 * lane + 256 * j) = v[j];
            if (OUT) *(GAS f32x4*)(OUT + (size_t)row * DM + 4 * lane + 256 * j) = v[j];
            v2u w; w.x = pk2(v[j].x, v[j].y); w.y = pk2(v[j].z, v[j].w); *(GAS v2u*)(XB + (size_t)row * DM + 4 * lane + 256 * j) = w; }
        if constexpr (ROUTER) {
            float g0 = 0.f, g1 = 0.f, g2 = 0.f, g3 = 0.f;
#pragma unroll 1
            for (int j = 0; j < 4; ++j)
#pragma unroll
                for (int q = 0; q < 4; ++q) { const f32x4 w = *(const GAS f32x4*)(wrg + (size_t)(4 * lane + 256 * j + q) * 4); const float xv = v[j][q]; g0 += xv * w.x; g1 += xv * w.y; g2 += xv * w.z; g3 += xv * w.w; }
            g0 = wsum(g0) + brg[0]; g1 = wsum(g1) + brg[1]; g2 = wsum(g2) + brg[2]; g3 = wsum(g3) + brg[3];
            int gs = 0; float gm = g0;
            if (g1 > gm) { gm = g1; gs = 1; } if (g2 > gm) { gm = g2; gs = 2; } if (g3 > gm) { gm = g3; gs = 3; }
            gs = __builtin_amdgcn_readfirstlane(gs);
            const float gate_g = 1.f / (__expf(g0 - gm) + __expf(g1 - gm) + __expf(g2 - gm) + __expf(g3 - gm));
            const float* we = wre + (size_t)gs * DM * 8;
            float e0 = 0.f, e1 = 0.f, e2 = 0.f, e3 = 0.f, e4 = 0.f, e5 = 0.f, e6 = 0.f, e7 = 0.f;
#pragma unroll 1
            for (int j = 0; j < 4; ++j)
#pragma unroll
                for (int q = 0; q < 4; ++q) { const float* wp = we + (size_t)(4 * lane + 256 * j + q) * 8; const f32x4 wa = *(const GAS f32x4*)wp, wb = *(const GAS f32x4*)(wp + 4); const float xv = v[j][q];
                    e0 += xv * wa.x; e1 += xv * wa.y; e2 += xv * wa.z; e3 += xv * wa.w; e4 += xv * wb.x; e5 += xv * wb.y; e6 += xv * wb.z; e7 += xv * wb.w; }
            const float* be = bre + gs * 8;
            e0 = wsum(e0) + be[0]; e1 = wsum(e1) + be[1]; e2 = wsum(e2) + be[2]; e3 = wsum(e3) + be[3]; e4 = wsum(e4) + be[4]; e5 = wsum(e5) + be[5]; e6 = wsum(e6) + be[6]; e7 = wsum(e7) + be[7];
            int i1 = 0; float v1 = e0;
            if (e1 > v1) { v1 = e1; i1 = 1; } if (e2 > v1) { v1 = e2; i1 = 2; } if (e3 > v1) { v1 = e3; i1 = 3; }
            if (e4 > v1) { v1 = e4; i1 = 4; } if (e5 > v1) { v1 = e5; i1 = 5; } if (e6 > v1) { v1 = e6; i1 = 6; } if (e7 > v1) { v1 = e7; i1 = 7; }
            int i2 = -1; float v2 = -3.0e38f;
            if (i1 != 0 && e0 > v2) { v2 = e0; i2 = 0; } if (i1 != 1 && e1 > v2) { v2 = e1; i2 = 1; } if (i1 != 2 && e2 > v2) { v2 = e2; i2 = 2; } if (i1 != 3 && e3 > v2) { v2 = e3; i2 = 3; }
            if (i1 != 4 && e4 > v2) { v2 = e4; i2 = 4; } if (i1 != 5 && e5 > v2) { v2 = e5; i2 = 5; } if (i1 != 6 && e6 > v2) { v2 = e6; i2 = 6; } if (i1 != 7 && e7 > v2) { v2 = e7; i2 = 7; }
            const float ex = __expf(v2 - v1);
            if (lane == 0) { gate[2 * row] = gate_g / (1.f + ex); gate[2 * row + 1] = gate_g * ex / (1.f + ex); }
            const int kk = k & 31;
            if (lane == 2 * kk) { myE = gs * 8 + i1; mySlot = 2 * row; }
            if (lane == 2 * kk + 1) { myE = gs * 8 + i2; mySlot = 2 * row + 1; }
            if (kk == 31 || row + NGW >= NTOK) {
                if (lane < 2 * (kk + 1)) { const unsigned p = atomicAdd(cnt + myE, 1u); list[(size_t)myE * LIST_CAP + p] = mySlot; }
            }
        }
    }
}
__device__ __forceinline__ void emix_phase(Frame& F, const bf16* H, bf16* CAT, const bf16* WSB, const float* lng, const float* lnb, const float* bsp) {
    frame_refresh(F);
    const int lane = F.lane, w = F.wave, fr = lane & 15, fq = lane >> 4;
    LAS unsigned char* BtL = F.lds;
    for (int u = blockIdx.x; u < 1024; u += F.G) {
        if (u < 512) {
            const int chunk = u >> 2, h = u & 3, tb = chunk * CHUNK;
            const int hl = lane - h * 16;
            float gch[8], bch[8];
            if (hl >= 0 && hl < 16) {
#pragma unroll
                for (int j = 0; j < 8; ++j) { gch[j] = lng[h * 128 + hl * 8 + j]; bch[j] = lnb[h * 128 + hl * 8 + j]; } }
            for (int rr = 0; rr < 16; ++rr) { const int r = w * 16 + rr;
                const v4u raw = *(const GAS v4u*)(H + (size_t)(tb + r) * DIN_E + 1024 + lane * 8);
                float x[8] = {bflo(raw.x), bfhi(raw.x), bflo(raw.y), bfhi(raw.y), bflo(raw.z), bfhi(raw.z), bflo(raw.w), bfhi(raw.w)};
                float s = 0.f;
#pragma unroll
                for (int j = 0; j < 8; ++j) s += x[j];
                const float mean = wsum(s) * (1.f / 512.f); float q = 0.f;
#pragma unroll
                for (int j = 0; j < 8; ++j) { x[j] -= mean; q += x[j] * x[j]; }
                const float rstd = 1.f / sqrtf(wsum(q) * (1.f / 512.f) + LN_EPS);
                if (hl >= 0 && hl < 16) {
#pragma unroll
                    for (int j = 0; j < 8; ++j) *(LAS bf16*)(BtL + (hl * 8 + j) * 272 + r * 2) = (bf16)f2bf(x[j] * rstd * gch[j] + bch[j]); }
            }
            LDS_WAIT(); __syncthreads();
            f32x4 acc[8];
#pragma unroll
            for (int nb = 0; nb < 8; ++nb) acc[nb] = (f32x4){0.f, 0.f, 0.f, 0.f};
            const bf16* wsrow = WSB + ((size_t)h * CHUNK + 16 * w + fr) * CHUNK;
#pragma unroll
            for (int s = 0; s < 4; ++s) { if (32 * s <= 16 * w + 15) {
                const bf16x8v af = *(const GAS bf16x8v*)(wsrow + 32 * s + 8 * fq);
#pragma unroll
                for (int nb = 0; nb < 8; ++nb) { const bf16x8v bfr = *(const LAS bf16x8v*)(BtL + (16 * nb + fr) * 272 + (32 * s + 8 * fq) * 2);
                    acc[nb] = __builtin_amdgcn_mfma_f32_16x16x32_bf16(bfr, af, acc[nb], 0, 0, 0); } } }
            const int t = tb + 16 * w + fr; const float bias = bsp[h * CHUNK + 16 * w + fr];
#pragma unroll
            for (int nb = 0; nb < 8; ++nb) { const int c = h * 128 + 16 * nb + 4 * fq;
                const v2u uv = *(const GAS v2u*)(H + (size_t)t * DIN_E + 512 + c);
                v2u o; o.x = pk2(bflo(uv.x) * (acc[nb][0] + bias), bfhi(uv.x) * (acc[nb][1] + bias)); o.y = pk2(bflo(uv.y) * (acc[nb][2] + bias), bfhi(uv.y) * (acc[nb][3] + bias));
                *(GAS v2u*)(CAT + (size_t)t * DM + 512 + c) = o; }
            __syncthreads();
        } else {
            const int uu = u - 512, chunk = uu >> 2, g = uu & 3, win = 2 << g, tb = chunk * CHUNK + 16 * w, s0 = tb & (SEQ - 1);
            const bf16* col = H + g * 128 + 2 * lane;
            float sx = 0.f, sy = 0.f;
            for (int j = 1; j < win; ++j) { if (s0 - j >= 0) { const unsigned a = *(const GAS unsigned*)(col + (size_t)(tb - j) * DIN_E); sx += bflo(a); sy += bfhi(a); } }
            for (int rr = 0; rr < 16; ++rr) { const int t = tb + rr, s = s0 + rr;
                const unsigned a = *(const GAS unsigned*)(col + (size_t)t * DIN_E); const float ax = bflo(a), ay = bfhi(a);
                sx += ax; sy += ay;
                const float inv = 1.f / (float)(s + 1 < win ? s + 1 : win);
                *(GAS unsigned*)(CAT + (size_t)t * DM + g * 128 + 2 * lane) = pk2(sx * inv - ax, sy * inv - ay);
                if (s - win + 1 >= 0) { const unsigned o = *(const GAS unsigned*)(col + (size_t)(t - win + 1) * DIN_E); sx -= bflo(o); sy -= bfhi(o); } }
        }
    }
}
__device__ __forceinline__ void conv_phase(Frame& F, const bf16* ZC, const bf16* BG, bf16* CAT, const float* cw, const float* cb) {
    frame_refresh(F);
    const size_t gtid = (size_t)F.vcu * (NWAVES * 64) + F.tid, nthr = (size_t)F.G * NWAVES * 64;
    for (size_t it = gtid; it < (size_t)NTOK * 128; it += nthr) { const int t = (int)(it >> 7), c8 = (int)(it & 127) * 8, s = t & (SEQ - 1);
        const size_t o = (size_t)t * DM + c8;
        const v4u z0 = *(const GAS v4u*)(ZC + o), bg = *(const GAS v4u*)(BG + o);
        v4u z1 = {0u, 0u, 0u, 0u}, z2 = {0u, 0u, 0u, 0u};
        if (s >= 1) z1 = *(const GAS v4u*)(ZC + o - DM);
        if (s >= 2) z2 = *(const GAS v4u*)(ZC + o - 2 * DM);
        float wv[24], bb[8];
#pragma unroll
        for (int j = 0; j < 6; ++j) { const f32x4 q = *(const GAS f32x4*)(cw + (size_t)c8 * 3 + 4 * j); wv[4 * j] = q.x; wv[4 * j + 1] = q.y; wv[4 * j + 2] = q.z; wv[4 * j + 3] = q.w; }
#pragma unroll
        for (int j = 0; j < 2; ++j) { const f32x4 q = *(const GAS f32x4*)(cb + c8 + 4 * j); bb[4 * j] = q.x; bb[4 * j + 1] = q.y; bb[4 * j + 2] = q.z; bb[4 * j + 3] = q.w; }
        const unsigned z0w[4] = {z0.x, z0.y, z0.z, z0.w}, z1w[4] = {z1.x, z1.y, z1.z, z1.w}, z2w[4] = {z2.x, z2.y, z2.z, z2.w}, bgw[4] = {bg.x, bg.y, bg.z, bg.w};
        unsigned ow[4];
#pragma unroll
        for (int p = 0; p < 4; ++p) {
            const float c0 = bb[2 * p] + bflo(z2w[p]) * wv[6 * p] + bflo(z1w[p]) * wv[6 * p + 1] + bflo(z0w[p]) * wv[6 * p + 2];
            const float c1 = bb[2 * p + 1] + bfhi(z2w[p]) * wv[6 * p + 3] + bfhi(z1w[p]) * wv[6 * p + 4] + bfhi(z0w[p]) * wv[6 * p + 5];
            ow[p] = pk2(bflo(bgw[p]) * c0, bfhi(bgw[p]) * c1); }
        v4u ov; ov.x = ow[0]; ov.y = ow[1]; ov.z = ow[2]; ov.w = ow[3];
        *(GAS v4u*)(CAT + o) = ov; }
}

__global__ void __launch_bounds__(NWAVES * 64, 2) mega(Args args) {
    extern __shared__ __attribute__((aligned(16))) unsigned char lds_raw[];
    Frame F;
    F.lds = (LAS unsigned char*)lds_raw;
    F.tid = threadIdx.x; F.lane = F.tid & 63; F.wave = __builtin_amdgcn_readfirstlane(F.tid >> 6);
    F.G = gridDim.x; { const int bx = blockIdx.x; F.vcu = (F.G % 8 == 0) ? (bx % 8) * (F.G / 8) + bx / 8 : bx; }
    F.ws = args.ws;
    unsigned char* ws = args.ws;
    unsigned* ctl = (unsigned*)(ws + WS_CTL);
    for (int u = F.tid; u < (LDS_BYTES - LDSCTL_OFF) / 4; u += NWAVES * 64) ((LAS unsigned*)(F.lds + LDSCTL_OFF))[u] = 0u;
    __syncthreads();
    const int lo = args.ph_lo, hi = args.ph_hi;
    XcdBarrier bar; bar.bar = ctl + CW_BAR; bar.x = 0; bar.st = nullptr;
    if (hi - lo > 1) bar = xcd_barrier_post(ctl + CW_BAR, (volatile LAS unsigned*)(F.lds + MISC_OFF) + 8);
#ifndef PHMASK
#define PHMASK 0x3fff
#endif
#define PHEN(k) ((PHMASK >> ((k) < 2 ? 12 + (k) : ((k) - 2) % NPL)) & 1)
#define RUN(k) (PHEN(k) && lo <= (k) && (k) < hi)
#define SEAM(k) do { if ((k) + 1 < hi) xcd_barrier(bar); } while (0)
    float* X = (float*)(ws + WS_X); bf16* XB = (bf16*)(ws + WS_XB); float* Y = (float*)(ws + WS_Y); bf16* CAT = (bf16*)(ws + WS_CAT);
    bf16* KALL = (bf16*)(ws + WS_KV); bf16* VTALL = KALL + (size_t)NMEM * DEPTH * DM; bf16* MEMB = (bf16*)(ws + WS_MEMB);
    int* LIST = (int*)(ws + WS_LIST); float* GATE = (float*)(ws + WS_GATE);
    unsigned char* SCR = ws + WS_SCR;
    LAS unsigned char* ring = F.lds;
    const int cblk = (int)blockIdx.x;

    if (RUN(0)) { prep_phase(F, args); SEAM(0); }
    if (RUN(1)) {
        { pg8::Gemm g{MEMB, (const bf16*)(ws + WS_WK), DM, DM, DM}; pg8::DenseOrder S; S.init(NMEM, DEPTH * DM, F.G, cblk, DM, DM);
          pg8::EpiBf16 E{KALL, DEPTH * DM, 1 << 30}; pg8::gemm_phase<pg8::EpiBf16, pg8::DenseOrder, false>(ring, g, S, E); }
        { pg8::Gemm g{(const bf16*)(ws + WS_WV), MEMB, DM, DM, DM}; pg8::DenseOrder S; S.init(DEPTH * DM, NMEM, F.G, (cblk + F.G / 2) % F.G, DM, DM);
          pg8::EpiBf16 E{VTALL, NMEM, 1 << 30}; pg8::gemm_phase<pg8::EpiBf16, pg8::DenseOrder, false>(ring, g, S, E); }
        SEAM(1);
    }
    for (int l = 0; l < DEPTH; ++l) {
        const int base = 2 + l * NPL, i = l >> 1;
        if (base + NPL <= lo || base >= hi) continue;
        const float* ln_g = args.in[18] + (size_t)l * 3 * DM; const float* ln_b = args.in[19] + (size_t)l * 3 * DM;
        if (RUN(base + 0)) {
            if ((l & 1) == 0) { pg8::Gemm g{XB, (const bf16*)(ws + WS_W_EIN) + (size_t)i * DIN_E * DM, DM, DM, DM}; pg8::DenseOrder S; S.init(NTOK, DIN_E, F.G, cblk, DM, DM);
                pg8::EpiBf16 E{(bf16*)SCR, DIN_E, 2}; pg8::gemm_phase<pg8::EpiBf16, pg8::DenseOrder, true>(ring, g, S, E); }
            else { pg8::Gemm g{XB, (const bf16*)(ws + WS_W_OIN) + (size_t)i * DIN_O * DM, DM, DM, DM}; pg8::DenseOrder S; S.init(NTOK, DIN_O, F.G, cblk, DM, DM);
                pg8::EpiPair<0> E{(bf16*)SCR, (bf16*)(SCR + 32 * MiB), DM, 8, DM}; pg8::gemm_phase<pg8::EpiPair<0>, pg8::DenseOrder, true>(ring, g, S, E); }
            SEAM(base + 0);
        }
        if (RUN(base + 1)) {
            if ((l & 1) == 0) emix_phase(F, (const bf16*)SCR, CAT, (const bf16*)(ws + WS_WSB) + (size_t)i * 4 * CHUNK * CHUNK, args.in[5] + (size_t)i * 512, args.in[6] + (size_t)i * 512, args.in[8] + (size_t)i * 4 * CHUNK);
            else conv_phase(F, (const bf16*)SCR, (const bf16*)(SCR + 32 * MiB), CAT, args.in[11] + (size_t)i * DM * 3, args.in[12] + (size_t)i * DM);
            SEAM(base + 1);
        }
        if (RUN(base + 2)) {
            const bf16* W = (l & 1) ? (const bf16*)(ws + WS_W_OOUT) + (size_t)i * DM * DM : (const bf16*)(ws + WS_W_EOUT) + (size_t)i * DM * DM;
            pg8::Gemm g{CAT, W, DM, DM, DM}; pg8::DenseOrder S; S.init(NTOK, DM, F.G, cblk, DM, DM);
            pg8::EpiResid E{l == 0 ? args.in[0] : X, Y, DM, ALPHA}; pg8::gemm_phase<pg8::EpiResid, pg8::DenseOrder, false>(ring, g, S, E);
            SEAM(base + 2);
        }
        if (RUN(base + 3)) { ln_phase<0, false>(F, Y, nullptr, ln_g, ln_b, X, XB, nullptr, nullptr, nullptr, nullptr, nullptr, nullptr, nullptr, nullptr); SEAM(base + 3); }
        if (RUN(base + 4)) {
            pg8::Gemm g{XB, (const bf16*)(ws + WS_WQ) + (size_t)l * DM * DM, DM, DM, DM}; pg8::DenseOrder S; S.init(NTOK, DM, F.G, cblk, DM, DM);
            pg8::EpiBf16 E{(bf16*)SCR, DM, 1 << 30}; pg8::gemm_phase<pg8::EpiBf16, pg8::DenseOrder, false>(ring, g, S, E);
            SEAM(base + 4);
        }
        if (RUN(base + 5)) {
            pg8::Gemm g{(const bf16*)SCR, KALL, DM, DEPTH * DM, XHD}; AttnOrder S{F.G, cblk, l, 0};
            pg8::EpiSoftmax E{(bf16*)(SCR + 64 * MiB), DM, 0.0625f * 1.4426950408889634f}; pg8::gemm_phase<pg8::EpiSoftmax, AttnOrder, false>(ring, g, S, E);
            SEAM(base + 5);
        }
        if (RUN(base + 6)) {
            pg8::Gemm g{(const bf16*)(SCR + 64 * MiB), VTALL, DM, NMEM, XHD}; AttnOrder S{F.G, cblk, l, 1};
            pg8::EpiBf16 E{(bf16*)(SCR + 32 * MiB), DM, 1 << 30}; pg8::gemm_phase<pg8::EpiBf16, AttnOrder, false>(ring, g, S, E);
            SEAM(base + 6);
        }
        if (RUN(base + 7)) {
            pg8::Gemm g{(const bf16*)(SCR + 32 * MiB), (const bf16*)(ws + WS_WO) + (size_t)l * DM * DM, DM, DM, DM}; pg8::DenseOrder S; S.init(NTOK, DM, F.G, cblk, DM, DM);
            pg8::EpiResid E{X, Y, DM, ALPHA}; pg8::gemm_phase<pg8::EpiResid, pg8::DenseOrder, false>(ring, g, S, E);
            SEAM(base + 7);
        }
        unsigned* cnt = ctl + CW_CNT + l * NEXP;
        if (RUN(base + 8)) {
            ln_phase<0, true>(F, Y, nullptr, ln_g + DM, ln_b + DM, X, XB, nullptr, args.in[20] + (size_t)l * DM * 4, args.in[21] + (size_t)l * 4, args.in[22] + (size_t)l * 4 * DM * 8, args.in[23] + (size_t)l * 32, cnt, LIST, GATE);
            SEAM(base + 8);
        }
        if (RUN(base + 9)) {
            moe_tables(F, cnt);
            const LAS int* tab = (const LAS int*)(F.lds + TAB_OFF);
            pg8::Gemm g{XB, (const bf16*)(ws + WS_W13) + (size_t)l * NEXP * DM * DM, DM, DM, DM};
            MoeOrder<true> S{F.G, cblk, 4, tab, tab + 40, LIST, (size_t)DM * DM * 2, DM};
            pg8::EpiMoe1 E{(bf16*)SCR, tab}; pg8::gemm_phase<pg8::EpiMoe1, MoeOrder<true>, true>(ring, g, S, E);
            SEAM(base + 9);
        }
        if (RUN(base + 10)) {
            moe_tables(F, cnt);
            const LAS int* tab = (const LAS int*)(F.lds + TAB_OFF);
            pg8::Gemm g{(const bf16*)SCR, (const bf16*)(ws + WS_W2) + (size_t)l * NEXP * DM * DEXP, DEXP, DEXP, DEXP};
            MoeOrder<false> S{F.G, cblk, 4, tab, tab + 40, LIST, (size_t)DM * DEXP * 2, DEXP};
            pg8::EpiMoe2 E{(bf16*)(SCR + 96 * MiB), LIST, GATE, LIST_CAP}; pg8::gemm_phase<pg8::EpiMoe2, MoeOrder<false>, true>(ring, g, S, E);
            SEAM(base + 10);
        }
        if (RUN(base + 11)) {
            ln_phase<1, false>(F, nullptr, (const bf16*)(SCR + 96 * MiB), ln_g + 2 * DM, ln_b + 2 * DM, X, XB, l == DEPTH - 1 ? args.out : nullptr, nullptr, nullptr, nullptr, nullptr, nullptr, nullptr, nullptr);
            SEAM(base + 11);
        }
    }
#undef RUN
#undef SEAM
}

#ifndef FAST_MASK
#define FAST_MASK 0x7ff
#endif
template <class P> static void ngemm(P p, int N, int Mmax, int Z, hipStream_t s) { static_assert(sizeof(P) % 8 == 0, "no tail padding"); hipLaunchKernelGGL(k_ngemm<P>, dim3(N / 128, (Mmax + 127) / 128, Z), dim3(256), 0, s, p); }

extern "C" void kernel_launch(void* const* d_in, const int* in_sizes, int n_in, void* d_out, int out_size, void* d_ws, size_t ws_size, hipStream_t stream) {
    static int grid = 0;
    if (grid == 0) {
        if (n_in != 27 || out_size != NTOK * DM || ws_size < WS_END2) { fprintf(stderr, "kernel_launch: unexpected shapes (n_in %d out %d ws %zu need %zu)\n", n_in, out_size, ws_size, (size_t)WS_END2); grid = -1; return; }
        int dev = 0, cus = 0, per_cu = 0;
        if (hipGetDevice(&dev) != hipSuccess || hipDeviceGetAttribute(&cus, hipDeviceAttributeMultiprocessorCount, dev) != hipSuccess) { grid = -1; return; }
        if (hipFuncSetAttribute((const void*)mega, hipFuncAttributeMaxDynamicSharedMemorySize, LDS_BYTES) != hipSuccess) { fprintf(stderr, "kernel_launch: hipFuncSetAttribute failed\n"); grid = -1; return; }
        if (hipOccupancyMaxActiveBlocksPerMultiprocessor(&per_cu, (const void*)mega, NWAVES * 64, LDS_BYTES) != hipSuccess || per_cu < 1) fprintf(stderr, "kernel_launch: occupancy query reports %d\n", per_cu);
        (void)hipGetLastError();
        grid = cus;
        if (grid != 256) fprintf(stderr, "kernel_launch: %d CUs (built for 256)\n", grid);
    }
    if (grid < 0) return;
    const float* in_x = (const float*)d_in[0]; const float* in_mem = (const float*)d_in[1];
    const float* w_in_even = (const float*)d_in[2]; const float* w_pool = (const float*)d_in[3]; const float* pool_scale = (const float*)d_in[4];
    const float* ln_v_g = (const float*)d_in[5]; const float* ln_v_b = (const float*)d_in[6]; const float* w_spatial = (const float*)d_in[7]; const float* b_spatial = (const float*)d_in[8];
    const float* w_out_even = (const float*)d_in[9]; const float* w_in_odd = (const float*)d_in[10]; const float* conv_w = (const float*)d_in[11]; const float* conv_b = (const float*)d_in[12];
    const float* w_out_odd = (const float*)d_in[13]; const float* wq = (const float*)d_in[14]; const float* wk = (const float*)d_in[15]; const float* wv = (const float*)d_in[16]; const float* wo = (const float*)d_in[17];
    const float* ln_g = (const float*)d_in[18]; const float* ln_b = (const float*)d_in[19]; const float* wr_group = (const float*)d_in[20]; const float* br_group = (const float*)d_in[21];
    const float* wr_expert = (const float*)d_in[22]; const float* br_expert = (const float*)d_in[23]; const float* w1 = (const float*)d_in[24]; const float* w3 = (const float*)d_in[25]; const float* w2 = (const float*)d_in[26];
    char* ws = (char*)d_ws;
    unsigned* ctl = (unsigned*)(ws + WS_CTL);
    float* X = (float*)(ws + WS_X); bf16* XB = (bf16*)(ws + WS_XB); float* Y = (float*)(ws + WS_Y); bf16* CAT = (bf16*)(ws + WS_CAT);
    bf16* KB = (bf16*)(ws + WS_KV); bf16* VTB = KB + (size_t)DEPTH * NMEM * DM; bf16* MEMB = (bf16*)(ws + WS_MEMB);
    int* LIST = (int*)(ws + WS_LIST); float* GATE = (float*)(ws + WS_GATE);
    char* SCR = ws + WS_SCR;
    (void)hipMemsetAsync(ctl, 0, CTL_BYTES, stream);
    Args a{};
    for (int i = 0; i < 27; ++i) a.in[i] = (const float*)d_in[i];
    a.out = (float*)d_out; a.ws = (unsigned char*)d_ws;
    auto phase = [&](int lo, int hi) { a.ph_lo = lo; a.ph_hi = hi; hipLaunchKernelGGL(mega, dim3(grid), dim3(NWAVES * 64), LDS_BYTES, stream, a); };
    constexpr unsigned FM = FAST_MASK;
    if (FM == 0x3ff) { phase(0, NPHASE); return; }
    if (FM & 1) { phase(0, 1); phase(1, 2); hipLaunchKernelGGL(k_cvt, dim3(2048), dim3(256), 0, stream, in_x, X, XB, (size_t)NTOK * DM); }
    else {
        hipLaunchKernelGGL(k_cvt, dim3(2048), dim3(256), 0, stream, in_x, X, XB, (size_t)NTOK * DM);
        hipLaunchKernelGGL(k_cvt, dim3(512), dim3(256), 0, stream, in_mem, (float*)nullptr, MEMB, (size_t)NMEM * DM);
        for (int l = 0; l < DEPTH; ++l) {
            ngemm(PBf16ToBf16{MEMB, wk + (size_t)l * DM * DM, KB + (size_t)l * DM, DM, DM, DM, NMEM, DEPTH * DM, 0}, DM, NMEM, 1, stream);
            ngemm(PBf16ToBf16{MEMB, wv + (size_t)l * DM * DM, VTB + (size_t)l * DM * NMEM, DM, DM, DM, NMEM, NMEM, 1}, DM, NMEM, 1, stream);
        }
    }
    for (int l = 0; l < DEPTH; ++l) {
        const int i = l / 2, base = 2 + l * NPL;
        if (FM & 2) { phase(base + 0, base + 1); phase(base + 1, base + 2); }
        else if (l % 2 == 0) {
            float* Hf = (float*)SCR; float* D = (float*)(SCR + 96 * MiB);
            ngemm(PBf16ToF32{XB, w_in_even + (size_t)i * DM * DIN_E, Hf, DM, DIN_E, DM, NTOK, DIN_E, 0}, DIN_E, NTOK, 1, stream);
            hipLaunchKernelGGL(k_even_pool, dim3(NTOK * 512 / 256), dim3(256), 0, stream, Hf, D);
            ngemm(PPool{D, w_pool + (size_t)i * 4 * 128 * 128, pool_scale + (size_t)i * 512, CAT}, 128, NTOK, 4, stream);
            hipLaunchKernelGGL(k_even_gelu_ln, dim3(NTOK / 4), dim3(256), 0, stream, Hf, ln_v_g + (size_t)i * 512, ln_v_b + (size_t)i * 512);
            hipLaunchKernelGGL(k_even_gate, dim3(NTOK * 512 / 256), dim3(256), 0, stream, Hf, w_spatial + (size_t)i * 4 * 128 * 128, b_spatial + (size_t)i * 4 * 128, CAT);
        } else {
            float* ZC = (float*)SCR; float* BG = (float*)(SCR + 64 * MiB);
            const float* W = w_in_odd + (size_t)i * DM * DIN_O;
            ngemm(PBf16ToF32{XB, W + DM, ZC, DM, DIN_O, DM, NTOK, DM, 0}, DM, NTOK, 1, stream);
            ngemm(PBf16MulF32{XB, W + 2 * DM, ZC, DM, DIN_O, DM, NTOK, DM, 0}, DM, NTOK, 1, stream);
            ngemm(PBf16ToF32{XB, W, BG, DM, DIN_O, DM, NTOK, DM, 0}, DM, NTOK, 1, stream);
            hipLaunchKernelGGL(k_odd_conv, dim3(NTOK * DM / 256), dim3(256), 0, stream, ZC, BG, conv_w + (size_t)i * DM * 3, conv_b + (size_t)i * DM, CAT);
        }
        if (FM & 4) phase(base + 2, base + 3);
        else ngemm(PResid{CAT, (l % 2 ? w_out_odd : w_out_even) + (size_t)i * DM * DM, l == 0 ? in_x : X, Y, DM, DM, DM, NTOK}, DM, NTOK, 1, stream);
        if (FM & 8) phase(base + 3, base + 4);
        else hipLaunchKernelGGL(k_ln, dim3(NTOK / 4), dim3(256), 0, stream, Y, (const float*)nullptr, (const bf16*)nullptr, ln_g + (size_t)(l * 3 + 0) * DM, ln_b + (size_t)(l * 3 + 0) * DM, X, XB, (float*)nullptr);
        bf16* Q = (bf16*)SCR; bf16* O = (bf16*)(SCR + 32 * MiB);
        if (FM & 16) phase(base + 4, base + 5);
        else ngemm(PBf16ToBf16{XB, wq + (size_t)l * DM * DM, Q, DM, DM, DM, NTOK, DM, 0}, DM, NTOK, 1, stream);
        if (FM & 32) { phase(base + 5, base + 6); phase(base + 6, base + 7); }
        else hipLaunchKernelGGL(k_attn, dim3(NTOK, NXH), dim3(256), 0, stream, Q, KB + (size_t)l * DM, DEPTH * DM, VTB + (size_t)l * DM * NMEM, O);
        if (FM & 64) phase(base + 7, base + 8);
        else ngemm(PResid{O, wo + (size_t)l * DM * DM, X, Y, DM, DM, DM, NTOK}, DM, NTOK, 1, stream);
        unsigned* cnt = ctl + CW_CNT + l * NEXP; unsigned* off = ctl + CW_OFF + l * (NEXP + 1);
        if (FM & 128) phase(base + 8, base + 9);
        else {
            hipLaunchKernelGGL(k_ln, dim3(NTOK / 4), dim3(256), 0, stream, Y, (const float*)nullptr, (const bf16*)nullptr, ln_g + (size_t)(l * 3 + 1) * DM, ln_b + (size_t)(l * 3 + 1) * DM, X, XB, (float*)nullptr);
            hipLaunchKernelGGL(k_router, dim3(NTOK / 4), dim3(256), 0, stream, X, wr_group + (size_t)l * DM * 4, br_group + (size_t)l * 4, wr_expert + (size_t)l * 4 * DM * 8, br_expert + (size_t)l * 32, cnt, LIST, GATE);
        }
        bf16* OUT2 = (bf16*)(SCR + 96 * MiB);
        if (FM & 256) { phase(base + 9, base + 10); phase(base + 10, base + 11); }
        else {
            float* HID = (float*)SCR;
            hipLaunchKernelGGL(k_offsets, dim3(1), dim3(64), 0, stream, cnt, off);
            ngemm(PMoe1{XB, LIST, cnt, off, w1 + (size_t)l * NEXP * DM * DEXP, HID, 0, 0}, DEXP, NTOK, NEXP, stream);
            ngemm(PMoe1{XB, LIST, cnt, off, w3 + (size_t)l * NEXP * DM * DEXP, HID, 1, 0}, DEXP, NTOK, NEXP, stream);
            ngemm(PMoe2{HID, LIST, cnt, off, w2 + (size_t)l * NEXP * DEXP * DM, GATE, OUT2}, DM, NTOK, NEXP, stream);
        }
        if (FM & 512) phase(base + 11, base + 12);
        else hipLaunchKernelGGL(k_ln, dim3(NTOK / 4), dim3(256), 0, stream, (const float*)nullptr, X, OUT2, ln_g + (size_t)(l * 3 + 2) * DM, ln_b + (size_t)(l * 3 + 2) * DM, X, XB, (l == DEPTH - 1) ? (float*)d_out : (float*)nullptr);
    }
}
```

```cpp
#include <hip/hip_runtime.h>
#include <cstdio>
#include <cstdint>
#include <cstddef>

typedef unsigned short bf16;
__device__ __forceinline__ unsigned f2bf(float f) { unsigned u = __builtin_bit_cast(unsigned, f); return (u + 0x7fffu + ((u >> 16) & 1u)) >> 16; }
__device__ __forceinline__ float bf2f(bf16 b) { return __builtin_bit_cast(float, ((unsigned)b) << 16); }

constexpr int DM = 1024, BATCH = 4, SEQ = 4096, NTOK = BATCH * SEQ, DEPTH = 4, MEM = 256, NMEM = BATCH * MEM;
constexpr int DPOOL = 512, DSG = 512, NHSG = 4, CHUNK = 128, DIN_E = DPOOL + 2 * DSG, DIN_O = 3 * DM;
constexpr int NXH = 4, XHD = 256, NGRP = 4, EPG = 8, NEXP = 32, DEXP = 512;
constexpr float ALPHA = 1.6817928305074290f;
constexpr float LN_EPS = 1e-5f;
constexpr int LIST_CAP = NTOK;

constexpr size_t MiB = 1u << 20;
constexpr size_t WS_CTL = 0, CTL_BYTES = 1 * MiB;
constexpr size_t WS_X = 1 * MiB;
constexpr size_t WS_XB = WS_X + 64 * MiB;
constexpr size_t WS_Y = WS_XB + 32 * MiB;
constexpr size_t WS_CAT = WS_Y + 64 * MiB;
constexpr size_t WS_KV = WS_CAT + 32 * MiB;
constexpr size_t WS_MEMB = WS_KV + 16 * MiB;
constexpr size_t WS_LIST = WS_MEMB + 2 * MiB;
constexpr size_t WS_GATE = WS_LIST + 2 * MiB;
constexpr size_t WS_SCR = WS_GATE + 1 * MiB;
constexpr size_t WS_END = WS_SCR + 160 * MiB;
constexpr int CW_CNT = 1024;
constexpr int CW_OFF = 2048;

template <class P>
__global__ __launch_bounds__(256) void k_ngemm(P p) {
    __shared__ float As[16][132];
    __shared__ float Bs[16][132];
    const int z = blockIdx.z, m0 = blockIdx.y * 128, n0 = blockIdx.x * 128;
    const int rows = p.rows(z);
    if (m0 >= rows) return;
    const float* B = p.b(z); const int ldb = p.ldb(); const int K = p.K();
    const int tid = threadIdx.x, tx = tid & 15, ty = tid >> 4;
    float acc[8][8];
#pragma unroll
    for (int i = 0; i < 8; ++i)
#pragma unroll
        for (int j = 0; j < 8; ++j) acc[i][j] = 0.f;
    for (int k0 = 0; k0 < K; k0 += 16) {
#pragma unroll
        for (int i = 0; i < 8; ++i) { const int idx = tid + i * 256, r = idx >> 4, kk = idx & 15; As[kk][r] = (m0 + r < rows) ? p.a(z, m0 + r, k0 + kk) : 0.f; }
#pragma unroll
        for (int i = 0; i < 8; ++i) { const int idx = tid + i * 256, kk = idx >> 7, n = idx & 127; Bs[kk][n] = B[(size_t)(k0 + kk) * ldb + n0 + n]; }
        __syncthreads();
#pragma unroll
        for (int kk = 0; kk < 16; ++kk) {
            float a[8], b[8];
#pragma unroll
            for (int i = 0; i < 8; ++i) a[i] = As[kk][ty + 16 * i];
#pragma unroll
            for (int j = 0; j < 8; ++j) b[j] = Bs[kk][tx + 16 * j];
#pragma unroll
            for (int i = 0; i < 8; ++i)
#pragma unroll
                for (int j = 0; j < 8; ++j) acc[i][j] += a[i] * b[j];
        }
        __syncthreads();
    }
#pragma unroll
    for (int i = 0; i < 8; ++i) { const int m = m0 + ty + 16 * i; if (m < rows) {
#pragma unroll
        for (int j = 0; j < 8; ++j) p.store(z, m, n0 + tx + 16 * j, acc[i][j]); } }
}

struct PBf16ToF32 {
    const bf16* A; const float* B; float* C; int lda, ldb_, K_, M, ldc, pad;
    __device__ int rows(int) const { return M; } __device__ const float* b(int) const { return B; } __device__ int ldb() const { return ldb_; } __device__ int K() const { return K_; }
    __device__ float a(int, int m, int k) const { return bf2f(A[(size_t)m * lda + k]); }
    __device__ void store(int, int m, int n, float v) const { C[(size_t)m * ldc + n] = v; }
};
struct PBf16MulF32 {
    const bf16* A; const float* B; float* C; int lda, ldb_, K_, M, ldc, pad;
    __device__ int rows(int) const { return M; } __device__ const float* b(int) const { return B; } __device__ int ldb() const { return ldb_; } __device__ int K() const { return K_; }
    __device__ float a(int, int m, int k) const { return bf2f(A[(size_t)m * lda + k]); }
    __device__ void store(int, int m, int n, float v) const { C[(size_t)m * ldc + n] *= v; }
};
struct PBf16ToBf16 {
    const bf16* A; const float* B; bf16* C; int lda, ldb_, K_, M, ldc, transpose;
    __device__ int rows(int) const { return M; } __device__ const float* b(int) const { return B; } __device__ int ldb() const { return ldb_; } __device__ int K() const { return K_; }
    __device__ float a(int, int m, int k) const { return bf2f(A[(size_t)m * lda + k]); }
    __device__ void store(int, int m, int n, float v) const { if (transpose) C[(size_t)n * ldc + m] = (bf16)f2bf(v); else C[(size_t)m * ldc + n] = (bf16)f2bf(v); }
};
struct PResid {
    const bf16* A; const float* B; const float* X; float* Y; int lda, ldb_, K_, M;
    __device__ int rows(int) const { return M; } __device__ const float* b(int) const { return B; } __device__ int ldb() const { return ldb_; } __device__ int K() const { return K_; }
    __device__ float a(int, int m, int k) const { return bf2f(A[(size_t)m * lda + k]); }
    __device__ void store(int, int m, int n, float v) const { Y[(size_t)m * DM + n] = ALPHA * X[(size_t)m * DM + n] + v; }
};
struct PPool {
    const float* D; const float* W; const float* scale; bf16* cat;
    __device__ int rows(int) const { return NTOK; } __device__ const float* b(int z) const { return W + (size_t)z * 128 * 128; } __device__ int ldb() const { return 128; } __device__ int K() const { return 128; }
    __device__ float a(int z, int m, int k) const { return D[(size_t)m * 512 + z * 128 + k]; }
    __device__ void store(int z, int m, int n, float v) const { cat[(size_t)m * DM + z * 128 + n] = (bf16)f2bf(v * scale[z * 128 + n]); }
};
struct PMoe1 {
    const bf16* xb; const int* list; const unsigned* cnt; const unsigned* off; const float* W; float* hid; int mode, pad;
    __device__ int rows(int z) const { return (int)cnt[z]; } __device__ const float* b(int z) const { return W + (size_t)z * DM * DEXP; } __device__ int ldb() const { return DEXP; } __device__ int K() const { return DM; }
    __device__ float a(int z, int m, int k) const { const int slot = list[(size_t)z * LIST_CAP + m]; return bf2f(xb[(size_t)(slot >> 1) * DM + k]); }
    __device__ void store(int z, int m, int n, float v) const { float* h = hid + (size_t)(off[z] + m) * DEXP + n; if (mode == 0) *h = v; else { const float g = *h; *h = g / (1.f + __expf(-g)) * v; } }
};
struct PMoe2 {
    const float* hid; const int* list; const unsigned* cnt; const unsigned* off; const float* W; const float* gate; bf16* out2;
    __device__ int rows(int z) const { return (int)cnt[z]; } __device__ const float* b(int z) const { return W + (size_t)z * DEXP * DM; } __device__ int ldb() const { return DM; } __device__ int K() const { return DEXP; }
    __device__ float a(int z, int m, int k) const { return hid[(size_t)(off[z] + m) * DEXP + k]; }
    __device__ void store(int z, int m, int n, float v) const { const int slot = list[(size_t)z * LIST_CAP + m]; out2[(size_t)slot * DM + n] = (bf16)f2bf(v * gate[slot]); }
};

__global__ void k_cvt(const float* in, float* outf, bf16* outb, size_t n) {
    for (size_t i = (size_t)blockIdx.x * blockDim.x + threadIdx.x; i < n; i += (size_t)gridDim.x * blockDim.x) { const float v = in[i]; if (outf) outf[i] = v; outb[i] = (bf16)f2bf(v); }
}
__device__ __forceinline__ float wave_sum(float v) {
#pragma unroll
    for (int o = 1; o < 64; o <<= 1) v += __shfl_xor(v, o);
    return v;
}
__device__ __forceinline__ float gelu_tanh(float x) { const float u = 0.7978845608028654f * (x + 0.044715f * x * x * x); return 0.5f * x * (1.f + tanhf(u)); }

__global__ __launch_bounds__(256) void k_ln(const float* Y, const float* resid, const bf16* add2, const float* g, const float* b, float* xf, bf16* xb, float* xf2) {
    const int row = blockIdx.x * 4 + (threadIdx.x >> 6), lane = threadIdx.x & 63;
    float v[16]; float s = 0.f;
#pragma unroll
    for (int j = 0; j < 16; ++j) { const int c = lane + 64 * j; float t;
        if (add2) t = ALPHA * resid[(size_t)row * DM + c] + bf2f(add2[(size_t)(2 * row) * DM + c]) + bf2f(add2[(size_t)(2 * row + 1) * DM + c]);
        else t = Y[(size_t)row * DM + c];
        v[j] = t; s += t; }
    const float mean = wave_sum(s) * (1.f / DM); float q = 0.f;
#pragma unroll
    for (int j = 0; j < 16; ++j) { const float d = v[j] - mean; q += d * d; }
    const float rstd = 1.f / sqrtf(wave_sum(q) * (1.f / DM) + LN_EPS);
#pragma unroll
    for (int j = 0; j < 16; ++j) { const int c = lane + 64 * j; const float o = (v[j] - mean) * rstd * g[c] + b[c]; xf[(size_t)row * DM + c] = o; xb[(size_t)row * DM + c] = (bf16)f2bf(o); if (xf2) xf2[(size_t)row * DM + c] = o; }
}

__global__ void k_even_pool(const float* Hf, float* D) {
    const size_t i = (size_t)blockIdx.x * blockDim.x + threadIdx.x; if (i >= (size_t)NTOK * 512) return;
    const int t = (int)(i / 512), ch = (int)(i % 512), g = ch / 128, w = 2 << g, s = t % SEQ, cnt = (s + 1 < w) ? s + 1 : w;
    float sum = 0.f; for (int j = 0; j < cnt; ++j) sum += Hf[(size_t)(t - j) * DIN_E + ch];
    D[i] = sum / (float)cnt - Hf[(size_t)t * DIN_E + ch];
}
__global__ __launch_bounds__(256) void k_even_gelu_ln(float* Hf, const float* lg, const float* lb) {
    const int row = blockIdx.x * 4 + (threadIdx.x >> 6), lane = threadIdx.x & 63;
    float* h = Hf + (size_t)row * DIN_E;
    for (int j = 0; j < 8; ++j) { const int c = 512 + lane + 64 * j; h[c] = gelu_tanh(h[c]); }
    float v[8]; float s = 0.f;
#pragma unroll
    for (int j = 0; j < 8; ++j) { v[j] = gelu_tanh(h[1024 + lane + 64 * j]); s += v[j]; }
    const float mean = wave_sum(s) * (1.f / 512.f); float q = 0.f;
#pragma unroll
    for (int j = 0; j < 8; ++j) { const float d = v[j] - mean; q += d * d; }
    const float rstd = 1.f / sqrtf(wave_sum(q) * (1.f / 512.f) + LN_EPS);
#pragma unroll
    for (int j = 0; j < 8; ++j) { const int c = lane + 64 * j; h[1024 + c] = (v[j] - mean) * rstd * lg[c] + lb[c]; }
}
__global__ void k_even_gate(const float* Hf, const float* wsp, const float* bsp, bf16* cat) {
    const size_t idx = (size_t)blockIdx.x * blockDim.x + threadIdx.x; if (idx >= (size_t)NTOK * 512) return;
    const int t = (int)(idx / 512), hc = (int)(idx % 512), h = hc / 128, i = t % CHUNK, tb = t - i;
    const float* wrow = wsp + ((size_t)h * CHUNK + i) * CHUNK;
    float sv = 0.f; for (int j = 0; j <= i; ++j) sv += wrow[j] * Hf[(size_t)(tb + j) * DIN_E + 1024 + hc];
    sv += bsp[h * CHUNK + i];
    cat[(size_t)t * DM + 512 + hc] = (bf16)f2bf(Hf[(size_t)t * DIN_E + 512 + hc] * sv);
}
__global__ void k_odd_conv(const float* zc, const float* bg, const float* cw, const float* cb, bf16* cat) {
    const size_t idx = (size_t)blockIdx.x * blockDim.x + threadIdx.x; if (idx >= (size_t)NTOK * DM) return;
    const int t = (int)(idx / DM), c = (int)(idx % DM), s = t % SEQ;
    float conv = cb[c] + zc[idx] * cw[c * 3 + 2];
    if (s >= 1) conv += zc[idx - DM] * cw[c * 3 + 1];
    if (s >= 2) conv += zc[idx - 2 * DM] * cw[c * 3 + 0];
    cat[idx] = (bf16)f2bf(bg[idx] * conv);
}
__global__ __launch_bounds__(256) void k_attn(const bf16* q, const bf16* K, int ldk, const bf16* VT, bf16* o) {
    __shared__ float qs[256]; __shared__ float ps[256]; __shared__ float red[8];
    const int t = blockIdx.x, h = blockIdx.y, b = t / SEQ, tid = threadIdx.x, lane = tid & 63, w = tid >> 6;
    qs[tid] = bf2f(q[(size_t)t * DM + h * XHD + tid]);
    __syncthreads();
    const uint4* kr = (const uint4*)(K + (size_t)(b * MEM + tid) * ldk + h * XHD);
    float s = 0.f;
    for (int d8 = 0; d8 < XHD / 8; ++d8) { const uint4 kv = kr[d8]; const unsigned w4[4] = {kv.x, kv.y, kv.z, kv.w};
#pragma unroll
        for (int j = 0; j < 4; ++j) { s += qs[d8 * 8 + 2 * j] * __builtin_bit_cast(float, w4[j] << 16); s += qs[d8 * 8 + 2 * j + 1] * __builtin_bit_cast(float, w4[j] & 0xffff0000u); } }
    s *= 0.0625f;
    float m = s;
#pragma unroll
    for (int off = 1; off < 64; off <<= 1) m = fmaxf(m, __shfl_xor(m, off));
    if (lane == 0) red[w] = m;
    __syncthreads();
    m = fmaxf(fmaxf(red[0], red[1]), fmaxf(red[2], red[3]));
    const float e = __expf(s - m);
    float sum = wave_sum(e);
    if (lane == 0) red[4 + w] = sum;
    ps[tid] = e;
    __syncthreads();
    sum = red[4] + red[5] + red[6] + red[7];
    const uint4* vr = (const uint4*)(VT + (size_t)(h * XHD + tid) * NMEM + b * MEM);
    float acc = 0.f;
    for (int j8 = 0; j8 < MEM / 8; ++j8) { const uint4 vv = vr[j8]; const unsigned w4[4] = {vv.x, vv.y, vv.z, vv.w};
#pragma unroll
        for (int j = 0; j < 4; ++j) { acc += ps[j8 * 8 + 2 * j] * __builtin_bit_cast(float, w4[j] << 16); acc += ps[j8 * 8 + 2 * j + 1] * __builtin_bit_cast(float, w4[j] & 0xffff0000u); } }
    o[(size_t)t * DM + h * XHD + tid] = (bf16)f2bf(acc / sum);
}
__global__ __launch_bounds__(256) void k_router(const float* x, const float* wrg, const float* brg, const float* wre, const float* bre, unsigned* cnt, int* list, float* gate) {
    const int t = blockIdx.x * 4 + (threadIdx.x >> 6), lane = threadIdx.x & 63;
    float g0 = 0.f, g1 = 0.f, g2 = 0.f, g3 = 0.f;
    for (int k = lane; k < DM; k += 64) { const float xv = x[(size_t)t * DM + k]; const float4 w = *(const float4*)(wrg + k * 4); g0 += xv * w.x; g1 += xv * w.y; g2 += xv * w.z; g3 += xv * w.w; }
    g0 = wave_sum(g0) + brg[0]; g1 = wave_sum(g1) + brg[1]; g2 = wave_sum(g2) + brg[2]; g3 = wave_sum(g3) + brg[3];
    int gs = 0; float gm = g0;
    if (g1 > gm) { gm = g1; gs = 1; }
    if (g2 > gm) { gm = g2; gs = 2; }
    if (g3 > gm) { gm = g3; gs = 3; }
    gs = __builtin_amdgcn_readfirstlane(gs);
    const float gate_g = 1.f / (__expf(g0 - gm) + __expf(g1 - gm) + __expf(g2 - gm) + __expf(g3 - gm));
    float e0 = 0.f, e1 = 0.f, e2 = 0.f, e3 = 0.f, e4 = 0.f, e5 = 0.f, e6 = 0.f, e7 = 0.f;
    const float* we = wre + (size_t)gs * DM * 8;
    for (int k = lane; k < DM; k += 64) { const float xv = x[(size_t)t * DM + k]; const float4 wa = *(const float4*)(we + k * 8), wb = *(const float4*)(we + k * 8 + 4);
        e0 += xv * wa.x; e1 += xv * wa.y; e2 += xv * wa.z; e3 += xv * wa.w; e4 += xv * wb.x; e5 += xv * wb.y; e6 += xv * wb.z; e7 += xv * wb.w; }
    const float* be = bre + gs * 8;
    e0 = wave_sum(e0) + be[0]; e1 = wave_sum(e1) + be[1]; e2 = wave_sum(e2) + be[2]; e3 = wave_sum(e3) + be[3];
    e4 = wave_sum(e4) + be[4]; e5 = wave_sum(e5) + be[5]; e6 = wave_sum(e6) + be[6]; e7 = wave_sum(e7) + be[7];
    int i1 = 0; float v1 = e0;
    if (e1 > v1) { v1 = e1; i1 = 1; } if (e2 > v1) { v1 = e2; i1 = 2; } if (e3 > v1) { v1 = e3; i1 = 3; }
    if (e4 > v1) { v1 = e4; i1 = 4; } if (e5 > v1) { v1 = e5; i1 = 5; } if (e6 > v1) { v1 = e6; i1 = 6; } if (e7 > v1) { v1 = e7; i1 = 7; }
    int i2 = -1; float v2 = -3.0e38f;
    if (i1 != 0 && e0 > v2) { v2 = e0; i2 = 0; } if (i1 != 1 && e1 > v2) { v2 = e1; i2 = 1; } if (i1 != 2 && e2 > v2) { v2 = e2; i2 = 2; } if (i1 != 3 && e3 > v2) { v2 = e3; i2 = 3; }
    if (i1 != 4 && e4 > v2) { v2 = e4; i2 = 4; } if (i1 != 5 && e5 > v2) { v2 = e5; i2 = 5; } if (i1 != 6 && e6 > v2) { v2 = e6; i2 = 6; } if (i1 != 7 && e7 > v2) { v2 = e7; i2 = 7; }
    if (lane == 0) {
        const float ex = __expf(v2 - v1), w1 = 1.f / (1.f + ex), w2 = ex / (1.f + ex);
        const int x1 = gs * 8 + i1, x2 = gs * 8 + i2;
        gate[2 * t] = gate_g * w1; gate[2 * t + 1] = gate_g * w2;
        const unsigned p1 = atomicAdd(cnt + x1, 1u); list[(size_t)x1 * LIST_CAP + p1] = 2 * t;
        const unsigned p2 = atomicAdd(cnt + x2, 1u); list[(size_t)x2 * LIST_CAP + p2] = 2 * t + 1;
    }
}
__global__ void k_offsets(const unsigned* cnt, unsigned* off) { if (threadIdx.x == 0 && blockIdx.x == 0) { unsigned a = 0; for (int e = 0; e < NEXP; ++e) { off[e] = a; a += (cnt[e] + 255u) / 256u * 256u; } off[NEXP] = a; } }

namespace pg8 {
#define PG8_LAS __attribute__((address_space(3)))
typedef unsigned short bf16_t;
typedef short bf16x8 __attribute__((ext_vector_type(8)));
typedef float f32x4 __attribute__((ext_vector_type(4)));
typedef float f32x2 __attribute__((ext_vector_type(2)));
typedef unsigned u32x4 __attribute__((ext_vector_type(4)));
typedef unsigned u32x2 __attribute__((ext_vector_type(2)));
constexpr int BM = 256, BK = 64, HALF = 128, HTB = HALF * BK * 2  , STAGE_BYTES = 8 * HTB, NXCD = 8, WGM = 8;

__host__ __device__ __forceinline__ int lds_byte(int r, int c) { const int st = (r >> 4) * 2 + (c >> 5), rr = r & 15, cc = c & 31, ob = rr * 64 + cc * 2; return st * 1024 + (ob ^ (((ob >> 9) & 1) << 5)); }
__host__ __device__ __forceinline__ void stage_rc(int b, int& R, int& C) { const int st = b / 1024, sb = b % 1024, swz = sb ^ (((sb >> 9) & 1) << 5); R = (st >> 1) * 16 + swz / 64; C = (st & 1) * 32 + (swz % 64) / 2; }
__host__ __device__ __forceinline__ int perm32(int rho) { const int n = rho >> 4, i = rho & 15; return 8 * (i >> 2) + 4 * n + (i & 3); }

struct Unit { int pm, pn, e, rows; };
struct Gemm { const bf16_t* A; const bf16_t* Bt; int lda, ldb, K; };

struct DenseOrder {
    static constexpr bool GATHER = false;
    int nM, nN, nwg, G, c, lda, ldb;
    __device__ void init(int M, int N, int G_, int c_, int lda_, int ldb_) { nM = M / BM; nN = N / BM; nwg = nM * nN; G = G_; c = c_; lda = lda_; ldb = ldb_; }
    __device__ bool next(int i, Unit& u) const {
        const long L = (long)i * G + c; if (L >= nwg) return false;
        int wgid = (int)L; { const int q = nwg / NXCD, r = nwg % NXCD, xcd = wgid % NXCD, off = wgid / NXCD; wgid = (xcd < r ? xcd * (q + 1) : r * (q + 1) + (xcd - r) * q) + off; }
        const int nig = WGM * nN, gid = wgid / nig, fm = gid * WGM, gsz = (nM - fm) < WGM ? (nM - fm) : WGM;
        u.pm = fm + ((wgid % nig) % gsz); u.pn = (wgid % nig) / gsz; u.e = 0; u.rows = BM; return true;
    }
    __device__ size_t a_off(const Unit& u) const { return (size_t)u.pm * BM * lda * 2; }
    __device__ size_t b_off(const Unit& u) const { return (size_t)u.pn * BM * ldb * 2; }
    __device__ int a_row(const Unit&, int) const { return 0; }
};

__device__ __forceinline__ unsigned cvt_pk_bf16(float lo, float hi) { unsigned r; asm volatile("v_cvt_pk_bf16_f32 %0, %1, %2" : "=v"(r) : "v"(lo), "v"(hi)); return r; }

template <class Epi, class Sched, bool ALIGN_EPI>
__device__ __forceinline__ void gemm_phase(PG8_LAS unsigned char* lds, const Gemm g, const Sched& S, const Epi& E) {
    int tid_ = threadIdx.x; asm volatile("" : "+v"(tid_));
    const int tid = tid_, wid = __builtin_amdgcn_readfirstlane(tid >> 6), lane = tid & 63, wr = wid >> 2, wc = wid & 3, fr = lane & 15, fq = lane >> 4;
    const int K = g.K, nt = K / BK;
    constexpr int NVA = Sched::GATHER ? 2 : 1;
    unsigned voffA[NVA][2], voffB[2];
#pragma unroll
    for (int i = 0; i < 2; ++i) { int R, C; stage_rc(tid * 16 + i * 8192, R, C); const int Rb = Epi::PERM ? ((R & ~31) + perm32(R & 31)) : R;
        voffA[0][i] = (unsigned)(R * g.lda + C) * 2u; voffB[i] = (unsigned)(Rb * g.ldb + C) * 2u; }
    const size_t kstep = (size_t)(BK * 2);
    const size_t hstepB = (size_t)HALF * g.ldb * 2;
    const size_t hstepA = Sched::GATHER ? (size_t)0 : (size_t)HALF * g.lda * 2;
#define PG8_VA1 voffA[NVA - 1]
#define PG8_GATHER_OFFS(dst, unit) do { int _t = tid; asm volatile("" : "+v"(_t)); _Pragma("unroll") for (int _h = 0; _h < 2; ++_h) _Pragma("unroll") for (int _i = 0; _i < 2; ++_i) { int _R, _C; stage_rc(_t * 16 + _i * 8192, _R, _C); \
        dst[_h][_i] = (unsigned)(S.a_row(unit, _R + _h * HALF) * g.lda + _C) * 2u; } } while (0)
    const unsigned ldsw = (unsigned)wid * 1024u;
    const int aoff = lds_byte(wr * 64 + fr, fq * 8), boff = lds_byte(wc * 32 + fr, fq * 8);
#define PG8_SA(b, h) (((b) * 2 + (h)) * HTB)
#define PG8_SB(b, h) ((4 + (b) * 2 + (h)) * HTB)
#define PG8_STAGE(bufoff, gbase, voff) do { _Pragma("unroll") for (int _i = 0; _i < 2; ++_i) \
        __builtin_amdgcn_global_load_lds((const unsigned*)((const char*)(gbase) + (voff)[_i]), (PG8_LAS unsigned*)(lds + (bufoff) + ldsw + _i * 8192), 16, 0, 0); } while (0)
#define PG8_LDA(dst, b, h) do { _Pragma("unroll") for (int m = 0; m < 4; ++m) _Pragma("unroll") for (int k = 0; k < 2; ++k) dst[m][k] = *(const PG8_LAS bf16x8*)(lds + PG8_SA(b, h) + aoff + m * 2048 + k * 1024); } while (0)
#define PG8_LDB(dst, b, h) do { _Pragma("unroll") for (int n = 0; n < 2; ++n) _Pragma("unroll") for (int k = 0; k < 2; ++k) dst[n][k] = *(const PG8_LAS bf16x8*)(lds + PG8_SB(b, h) + boff + n * 2048 + k * 1024); } while (0)
#define PG8_MMA(ai, bj, At, Bt) do { __builtin_amdgcn_s_setprio(1); _Pragma("unroll") for (int m = 0; m < 4; ++m) _Pragma("unroll") for (int n = 0; n < 2; ++n) _Pragma("unroll") for (int k = 0; k < 2; ++k) \
        acc[ai][bj][m][n] = __builtin_amdgcn_mfma_f32_16x16x32_bf16(Bt[n][k], At[m][k], acc[ai][bj][m][n], 0, 0, 0); __builtin_amdgcn_s_setprio(0); } while (0)
#define PG8_WAIT_V(n) asm volatile("s_waitcnt vmcnt(" #n ")" ::: "memory")
#define PG8_WAIT_L(n) asm volatile("s_waitcnt lgkmcnt(" #n ")" ::: "memory")
#define PG8_BAR __builtin_amdgcn_s_barrier()
#define PG8_SCHED __builtin_amdgcn_sched_barrier(0)
    Unit cur, nxt; int ui = 0;
    if (!S.next(0, cur)) return;
    f32x4 acc[2][2][4][2];
#pragma unroll
    for (int a = 0; a < 2; ++a)
#pragma unroll
        for (int b = 0; b < 2; ++b)
#pragma unroll
            for (int m = 0; m < 4; ++m)
#pragma unroll
                for (int n = 0; n < 2; ++n) acc[a][b][m][n] = (f32x4){0.f, 0.f, 0.f, 0.f};
    bf16x8 At[4][2], B0[2][2], B1[2][2];
    const char* cA = (const char*)g.A + S.a_off(cur); const char* cB = (const char*)g.Bt + S.b_off(cur);
    if constexpr (Sched::GATHER) { PG8_GATHER_OFFS(voffA, cur); }
    PG8_STAGE(PG8_SB(0, 0), cB, voffB); PG8_STAGE(PG8_SB(0, 1), cB + hstepB, voffB); PG8_STAGE(PG8_SA(0, 0), cA, voffA[0]); PG8_STAGE(PG8_SA(0, 1), cA + hstepA, PG8_VA1);
    if (wr == 1) PG8_BAR;
    PG8_WAIT_V(2); PG8_BAR;
    PG8_STAGE(PG8_SB(1, 0), cB + kstep, voffB); PG8_STAGE(PG8_SA(1, 0), cA + kstep, voffA[0]); PG8_STAGE(PG8_SB(1, 1), cB + hstepB + kstep, voffB);
    PG8_WAIT_V(6); PG8_BAR;
    for (;;) {
        const bool has_next = S.next(ui + 1, nxt);
        const char* nA = has_next ? (const char*)g.A + S.a_off(nxt) : cA; const char* nB = has_next ? (const char*)g.Bt + S.b_off(nxt) : cB;
        for (int t = 0; t < nt; t += 2) {
            const bool last = (t == nt - 2);
            const char* a1 = cA + (size_t)(t + 1) * kstep;
            const char* a2 = last ? nA : cA + (size_t)(t + 2) * kstep; const char* b2 = last ? nB : cB + (size_t)(t + 2) * kstep;
            const char* a3 = a2 + kstep; const char* b3 = b2 + kstep;
            unsigned nvo[2][2];
            if constexpr (Sched::GATHER) { if (last && has_next) { PG8_GATHER_OFFS(nvo, nxt); } }
            PG8_LDB(B0, 0, 0); PG8_LDB(B1, 0, 1); PG8_SCHED; PG8_LDA(At, 0, 0); PG8_STAGE(PG8_SA(1, 1), a1 + hstepA, PG8_VA1);
            PG8_WAIT_V(8); PG8_WAIT_L(0); PG8_BAR; PG8_MMA(0, 0, At, B0); PG8_MMA(0, 1, At, B1); PG8_BAR; PG8_SCHED;
            if constexpr (Sched::GATHER) { if (last && has_next) {
#pragma unroll
                for (int h = 0; h < NVA; ++h)
#pragma unroll
                    for (int i = 0; i < 2; ++i) voffA[h][i] = nvo[h][i]; } }
            PG8_LDA(At, 0, 1); PG8_STAGE(PG8_SB(0, 0), b2, voffB); PG8_STAGE(PG8_SB(0, 1), b2 + hstepB, voffB); PG8_STAGE(PG8_SA(0, 0), a2, voffA[0]);
            PG8_WAIT_V(8); PG8_WAIT_L(0); PG8_BAR; PG8_MMA(1, 0, At, B0); PG8_MMA(1, 1, At, B1); PG8_BAR; PG8_SCHED;
            PG8_LDB(B0, 1, 0); PG8_LDB(B1, 1, 1); PG8_SCHED; PG8_LDA(At, 1, 0); PG8_STAGE(PG8_SA(0, 1), a2 + hstepA, PG8_VA1);
            PG8_WAIT_V(8); PG8_WAIT_L(0); PG8_BAR; PG8_MMA(0, 0, At, B0); PG8_MMA(0, 1, At, B1); PG8_BAR; PG8_SCHED;
            PG8_LDA(At, 1, 1); PG8_STAGE(PG8_SB(1, 0), b3, voffB); PG8_STAGE(PG8_SB(1, 1), b3 + hstepB, voffB); PG8_STAGE(PG8_SA(1, 0), a3, voffA[0]);
            PG8_WAIT_V(8); PG8_WAIT_L(0); PG8_BAR; PG8_MMA(1, 0, At, B0); PG8_MMA(1, 1, At, B1); PG8_BAR; PG8_SCHED;
        }
        if constexpr (ALIGN_EPI) { if (wr == 0) PG8_BAR; }
        if constexpr (!Epi::AFTER_DRAIN) { E(acc, cur, wr, wc, fr, fq); }
        if (!has_next) break;
#pragma unroll
        for (int a = 0; a < 2; ++a)
#pragma unroll
            for (int b = 0; b < 2; ++b)
#pragma unroll
                for (int m = 0; m < 4; ++m)
#pragma unroll
                    for (int n = 0; n < 2; ++n) acc[a][b][m][n] = (f32x4){0.f, 0.f, 0.f, 0.f};
        cur = nxt; cA = nA; cB = nB; ++ui;
        if constexpr (ALIGN_EPI) { if (wr == 1) PG8_BAR; }
    }
    PG8_WAIT_V(0);
    if constexpr (!ALIGN_EPI) { if (wr == 0) PG8_BAR; }
    PG8_BAR;
    if constexpr (Epi::AFTER_DRAIN) { E.fused(acc, cur, wr, wc, fr, fq, lds, wid, lane); }
#undef PG8_SA
#undef PG8_VA1
#undef PG8_GATHER_OFFS
#undef PG8_SB
#undef PG8_STAGE
#undef PG8_LDA
#undef PG8_LDB
#undef PG8_MMA
#undef PG8_WAIT_V
#undef PG8_WAIT_L
#undef PG8_BAR
#undef PG8_SCHED
}
}
namespace pg8 {
__device__ __forceinline__ float gelu_tanh_f(float x) {
    const float u = x * (0.7978845608028654f + 0.035677408136300125f * x * x);
    const float e = __builtin_amdgcn_exp2f(-2.8853900817779268f * u);
    return x * __builtin_amdgcn_rcpf(1.0f + e);
}
__device__ __forceinline__ float silu_f(float x) { return x * __builtin_amdgcn_rcpf(1.0f + __builtin_amdgcn_exp2f(-1.4426950408889634f * x)); }

struct EpiResid {
    static constexpr bool PERM = false, AFTER_DRAIN = false;
    const float* X; float* Y; int ldc; float alpha;
    __device__ __forceinline__ void operator()(const f32x4 (&acc)[2][2][4][2], const Unit& u, int wr, int wc, int fr, int fq) const {
        const int row0 = u.pm * BM + wr * 64 + fr, col0 = u.pn * BM + wc * 32 + 4 * fq;
#pragma unroll
        for (int ai = 0; ai < 2; ++ai)
#pragma unroll
            for (int m = 0; m < 4; ++m) { const size_t off = (size_t)(row0 + ai * HALF + m * 16) * ldc + col0;
#pragma unroll
                for (int bj = 0; bj < 2; ++bj)
#pragma unroll
                    for (int n = 0; n < 2; ++n) { const f32x4 xv = *(const f32x4*)(X + off + bj * HALF + n * 16); *(f32x4*)(Y + off + bj * HALF + n * 16) = xv * alpha + acc[ai][bj][m][n]; }
                asm volatile("" ::: "memory"); }
    }
};
struct EpiBf16 {
    static constexpr bool PERM = true, AFTER_DRAIN = false;
    bf16_t* O; int ldc; int gelu_from;
    __device__ __forceinline__ void operator()(const f32x4 (&acc)[2][2][4][2], const Unit& u, int wr, int wc, int fr, int fq) const {
        const int row0 = u.pm * BM + wr * 64 + fr, col0 = u.pn * BM + wc * 32 + 8 * fq;
        const bool act = u.pn >= gelu_from;
#pragma unroll
        for (int ai = 0; ai < 2; ++ai)
#pragma unroll
            for (int m = 0; m < 4; ++m) { bf16_t* rowp = O + (size_t)(row0 + ai * HALF + m * 16) * ldc + col0;
#pragma unroll
                for (int bj = 0; bj < 2; ++bj) { f32x4 v0 = acc[ai][bj][m][0], v1 = acc[ai][bj][m][1];
                    if (act) {
#pragma unroll
                        for (int j = 0; j < 4; ++j) { v0[j] = gelu_tanh_f(v0[j]); v1[j] = gelu_tanh_f(v1[j]); } }
                    u32x4 w; w.x = cvt_pk_bf16(v0[0], v0[1]); w.y = cvt_pk_bf16(v0[2], v0[3]); w.z = cvt_pk_bf16(v1[0], v1[1]); w.w = cvt_pk_bf16(v1[2], v1[3]);
                    *(u32x4*)(rowp + bj * HALF) = w; } }
    }
};
template <int MODE> struct EpiPair {
    static constexpr bool PERM = true, AFTER_DRAIN = false;
    bf16_t* O; bf16_t* O2; int ldc, npair, ldc2;
    __device__ __forceinline__ void operator()(const f32x4 (&acc)[2][2][4][2], const Unit& u, int wr, int wc, int fr, int fq) const {
        const int row0 = u.pm * BM + wr * 64 + fr;
        if (u.pn < npair) {
            const int col0 = u.pn * HALF + wc * 32 + 8 * fq;
#pragma unroll
            for (int ai = 0; ai < 2; ++ai)
#pragma unroll
                for (int m = 0; m < 4; ++m) { bf16_t* rowp = O + (size_t)(row0 + ai * HALF + m * 16) * ldc + col0;
                    f32x4 v0, v1;
#pragma unroll
                    for (int j = 0; j < 4; ++j) { const float a0 = acc[ai][0][m][0][j], a1 = acc[ai][0][m][1][j];
                        v0[j] = (MODE == 1 ? silu_f(a0) : a0) * acc[ai][1][m][0][j]; v1[j] = (MODE == 1 ? silu_f(a1) : a1) * acc[ai][1][m][1][j]; }
                    u32x4 w; w.x = cvt_pk_bf16(v0[0], v0[1]); w.y = cvt_pk_bf16(v0[2], v0[3]); w.z = cvt_pk_bf16(v1[0], v1[1]); w.w = cvt_pk_bf16(v1[2], v1[3]);
                    *(u32x4*)rowp = w; }
        } else {
            const int col0 = (u.pn - npair) * BM + wc * 32 + 8 * fq;
#pragma unroll
            for (int ai = 0; ai < 2; ++ai)
#pragma unroll
                for (int m = 0; m < 4; ++m) { bf16_t* rowp = O2 + (size_t)(row0 + ai * HALF + m * 16) * ldc2 + col0;
#pragma unroll
                    for (int bj = 0; bj < 2; ++bj) { const f32x4 v0 = acc[ai][bj][m][0], v1 = acc[ai][bj][m][1];
                        u32x4 w; w.x = cvt_pk_bf16(v0[0], v0[1]); w.y = cvt_pk_bf16(v0[2], v0[3]); w.z = cvt_pk_bf16(v1[0], v1[1]); w.w = cvt_pk_bf16(v1[2], v1[3]);
                        *(u32x4*)(rowp + bj * HALF) = w; } }
        }
    }
};
struct EpiMoe1 {
    static constexpr bool PERM = true, AFTER_DRAIN = false;
    bf16_t* HID; const PG8_LAS int* tab;
    __device__ __forceinline__ void operator()(const f32x4 (&acc)[2][2][4][2], const Unit& u, int wr, int wc, int fr, int fq) const {
        const int row0 = (tab[u.e] + u.pm) * BM + wr * 64 + fr, col0 = u.pn * HALF + wc * 32 + 8 * fq;
#pragma unroll
        for (int ai = 0; ai < 2; ++ai)
#pragma unroll
            for (int m = 0; m < 4; ++m) { bf16_t* rowp = HID + (size_t)(row0 + ai * HALF + m * 16) * 512 + col0;
                f32x4 v0, v1;
#pragma unroll
                for (int j = 0; j < 4; ++j) { v0[j] = silu_f(acc[ai][0][m][0][j]) * acc[ai][1][m][0][j]; v1[j] = silu_f(acc[ai][0][m][1][j]) * acc[ai][1][m][1][j]; }
                u32x4 w; w.x = cvt_pk_bf16(v0[0], v0[1]); w.y = cvt_pk_bf16(v0[2], v0[3]); w.z = cvt_pk_bf16(v1[0], v1[1]); w.w = cvt_pk_bf16(v1[2], v1[3]);
                *(u32x4*)rowp = w; }
    }
};
struct EpiMoe2 {
    static constexpr bool PERM = true, AFTER_DRAIN = false;
    bf16_t* OUT2; const int* list; const float* gate; int cap;
    __device__ __forceinline__ void operator()(const f32x4 (&acc)[2][2][4][2], const Unit& u, int wr, int wc, int fr, int fq) const {
        const int r0 = wr * 64 + fr, col0 = u.pn * BM + wc * 32 + 8 * fq;
        const int* lp = list + (size_t)u.e * cap + u.pm * BM;
#pragma unroll
        for (int ai = 0; ai < 2; ++ai)
#pragma unroll
            for (int m = 0; m < 4; ++m) { const int r = r0 + ai * HALF + m * 16;
                if (r < u.rows) { const int slot = lp[r]; const float gt = gate[slot]; bf16_t* rowp = OUT2 + (size_t)slot * 1024 + col0;
#pragma unroll
                    for (int bj = 0; bj < 2; ++bj) { const f32x4 v0 = acc[ai][bj][m][0] * gt, v1 = acc[ai][bj][m][1] * gt;
                        u32x4 w; w.x = cvt_pk_bf16(v0[0], v0[1]); w.y = cvt_pk_bf16(v0[2], v0[3]); w.z = cvt_pk_bf16(v1[0], v1[1]); w.w = cvt_pk_bf16(v1[2], v1[3]);
                        *(u32x4*)(rowp + bj * HALF) = w; } } }
    }
};
struct EpiSoftmax {
    static constexpr bool PERM = true, AFTER_DRAIN = true;
    bf16_t* P; int ldc; float scale_log2e;
    __device__ __forceinline__ void fused(f32x4 (&acc)[2][2][4][2], const Unit& u, int wr, int wc, int fr, int fq, PG8_LAS unsigned char* lds, int wid, int lane) const {
        PG8_LAS float* PM = (PG8_LAS float*)lds;
        PG8_LAS float* PS = (PG8_LAS float*)(lds + 4096);
#pragma unroll
        for (int ai = 0; ai < 2; ++ai)
#pragma unroll
            for (int m = 0; m < 4; ++m) { float mx = -3.0e38f;
#pragma unroll
                for (int bj = 0; bj < 2; ++bj)
#pragma unroll
                    for (int n = 0; n < 2; ++n) { const f32x4 x = acc[ai][bj][m][n]; mx = fmaxf(mx, fmaxf(fmaxf(x[0], x[1]), fmaxf(x[2], x[3]))); }
                mx = fmaxf(mx, __shfl_xor(mx, 16)); mx = fmaxf(mx, __shfl_xor(mx, 32));
                if (fq == 0) PM[(ai * HALF + wr * 64 + m * 16 + fr) * 4 + wc] = mx; }
        asm volatile("s_waitcnt lgkmcnt(0)" ::: "memory"); __builtin_amdgcn_s_barrier(); asm volatile("" ::: "memory");
#pragma unroll
        for (int ai = 0; ai < 2; ++ai)
#pragma unroll
            for (int m = 0; m < 4; ++m) { const int r = ai * HALF + wr * 64 + m * 16 + fr; const f32x4 pm = *(const PG8_LAS f32x4*)(PM + r * 4);
                const float mx = fmaxf(fmaxf(pm[0], pm[1]), fmaxf(pm[2], pm[3])) * scale_log2e; float s = 0.f;
#pragma unroll
                for (int bj = 0; bj < 2; ++bj)
#pragma unroll
                    for (int n = 0; n < 2; ++n) { f32x4 x = acc[ai][bj][m][n];
#pragma unroll
                        for (int j = 0; j < 4; ++j) { x[j] = __builtin_amdgcn_exp2f(x[j] * scale_log2e - mx); s += x[j]; }
                        acc[ai][bj][m][n] = x; }
                s += __shfl_xor(s, 16); s += __shfl_xor(s, 32);
                if (fq == 0) PS[r * 4 + wc] = s; }
        asm volatile("s_waitcnt lgkmcnt(0)" ::: "memory"); __builtin_amdgcn_s_barrier(); asm volatile("" ::: "memory");
        const int row0 = u.pm * BM + wr * 64 + fr, col0 = u.pn * BM + wc * 32 + 8 * fq;
#pragma unroll
        for (int ai = 0; ai < 2; ++ai)
#pragma unroll
            for (int m = 0; m < 4; ++m) { const int r = ai * HALF + wr * 64 + m * 16 + fr; const f32x4 ps = *(const PG8_LAS f32x4*)(PS + r * 4);
                const float inv = 1.0f / ((ps[0] + ps[1]) + (ps[2] + ps[3])); bf16_t* rowp = P + (size_t)(row0 + ai * HALF + m * 16) * ldc + col0;
#pragma unroll
                for (int bj = 0; bj < 2; ++bj) { const f32x4 v0 = acc[ai][bj][m][0] * inv, v1 = acc[ai][bj][m][1] * inv;
                    u32x4 w; w.x = cvt_pk_bf16(v0[0], v0[1]); w.y = cvt_pk_bf16(v0[2], v0[3]); w.z = cvt_pk_bf16(v1[0], v1[1]); w.w = cvt_pk_bf16(v1[2], v1[3]);
                    *(u32x4*)(rowp + bj * HALF) = w; } }
    }
};
}
constexpr int NWAVES = 8;
constexpr int NPL = 12;
constexpr int NPHASE = 2 + DEPTH * NPL;
constexpr size_t WS_W_EIN = WS_END;
constexpr size_t WS_W_EOUT = WS_W_EIN + 6 * MiB;
constexpr size_t WS_W_OIN = WS_W_EOUT + 4 * MiB;
constexpr size_t WS_W_OOUT = WS_W_OIN + 12 * MiB;
constexpr size_t WS_WSB = WS_W_OOUT + 4 * MiB;
constexpr size_t WS_WQ = WS_WSB + 1 * MiB;
constexpr size_t WS_WO = WS_WQ + 8 * MiB;
constexpr size_t WS_WK = WS_WO + 8 * MiB;
constexpr size_t WS_WV = WS_WK + 8 * MiB;
constexpr size_t WS_W13 = WS_WV + 8 * MiB;
constexpr size_t WS_W2 = WS_W13 + 256 * MiB;
constexpr size_t WS_END2 = WS_W2 + 128 * MiB;
constexpr int CW_BAR = 8192;
constexpr int RING_BYTES = 131072, LDSCTL_OFF = RING_BYTES, MISC_OFF = LDSCTL_OFF + 320, TAB_OFF = LDSCTL_OFF + 1024;
constexpr int LDS_BYTES = 147456;

#define GAS __attribute__((address_space(1)))
#define LAS __attribute__((address_space(3)))
typedef unsigned v4u __attribute__((ext_vector_type(4)));
typedef unsigned v2u __attribute__((ext_vector_type(2)));
typedef float f32x4 __attribute__((ext_vector_type(4)));
typedef short bf16x8v __attribute__((ext_vector_type(8)));
#define LDS_WAIT() asm volatile("s_waitcnt lgkmcnt(0)" ::: "memory")
#define VM_WAIT() asm volatile("s_waitcnt vmcnt(0)" ::: "memory")
__device__ __forceinline__ unsigned pk2(float lo, float hi) { return f2bf(lo) | (f2bf(hi) << 16); }
__device__ __forceinline__ float bflo(unsigned w) { return __builtin_bit_cast(float, w << 16); }
__device__ __forceinline__ float bfhi(unsigned w) { return __builtin_bit_cast(float, w & 0xffff0000u); }

#define XB_TMO      128
#define XB_XCNT(j)  (256  + 64 * (j))
#define XB_XSUB(j)  (1280 + 64 * (j))
#define XB_XGEN(j)  (2304 + 64 * (j))
#define XB_TOP      3328
#define XB_TOPGEN   3392
#define XCD_BAR_WORDS 3456
#define XB_SPIN_CAP (1u << 18)

__device__ __forceinline__ unsigned xb_ld(unsigned* p)              { return __hip_atomic_load(p, __ATOMIC_RELAXED, __HIP_MEMORY_SCOPE_AGENT); }
__device__ __forceinline__ unsigned xb_add(unsigned* p, unsigned v) { return __hip_atomic_fetch_add(p, v, __ATOMIC_RELAXED, __HIP_MEMORY_SCOPE_AGENT); }
__device__ __forceinline__ unsigned xb_xcc_id() { return (unsigned)__builtin_amdgcn_s_getreg((3 << 11) | 20) & 0xFu; }
#define XB_SPIN(cond, bar) do { unsigned _sp = 0; while (cond) { __builtin_amdgcn_s_sleep(1); \
    if ((++_sp & 255u) == 0u) { if (xb_ld(&(bar)[XB_TMO])) break; if (_sp > XB_SPIN_CAP) { atomicAdd(&(bar)[XB_TMO], 1u); break; } } } } while (0)

struct XcdBarrier {
    unsigned* bar; unsigned x;
    volatile LAS unsigned* st;
};

__device__ __forceinline__ XcdBarrier xcd_barrier_post(unsigned* bar, volatile LAS unsigned* st) {
    XcdBarrier b; b.bar = bar; b.x = xb_xcc_id(); b.st = st;
    if (threadIdx.x == 0) (void)xb_add(&bar[XB_XCNT(b.x)], 1u);
    return b;
}
__device__ __forceinline__ void xcd_barrier_complete(unsigned* bar, unsigned x, unsigned& nloc, unsigned& nx) {
    const unsigned G = gridDim.x * gridDim.y * gridDim.z;
    unsigned sum, cnt, mine, sp = 0u;
    for (;;) {
        sum = 0u; cnt = 0u; mine = 0u;
#pragma unroll
        for (unsigned j = 0; j < 16; ++j) { const unsigned c = xb_ld(&bar[XB_XCNT(j)]); sum += c; cnt += (c > 0u) ? 1u : 0u; mine = (j == x) ? c : mine; }
        if (sum == G) break;
        __builtin_amdgcn_s_sleep(1);
        if ((++sp & 255u) == 0u) { if (xb_ld(&bar[XB_TMO])) break; if (sp > XB_SPIN_CAP) { atomicAdd(&bar[XB_TMO], 1u); break; } }
    }
    nloc = mine > 0u ? mine : 1u; nx = cnt > 0u ? cnt : 1u;
}

__device__ __forceinline__ void xcd_barrier(const XcdBarrier& b) {
    asm volatile("s_waitcnt vmcnt(0)" ::: "memory");
    __syncthreads();
    if (threadIdx.x == 0) {
        unsigned* bar = b.bar;
        __builtin_amdgcn_s_waitcnt(0);
        unsigned nloc = b.st[0], nx = b.st[1];
        if (nloc == 0u) { xcd_barrier_complete(bar, b.x, nloc, nx); b.st[0] = nloc; b.st[1] = nx; }
        const unsigned old = xb_add(&bar[XB_XSUB(b.x)], 1u);
        const unsigned gen = old / nloc;
        if (old + 1u == (gen + 1u) * nloc) {
            __builtin_amdgcn_fence(__ATOMIC_RELEASE, "agent");
            asm volatile("s_waitcnt vmcnt(0)" ::: "memory");
            const unsigned og = xb_add(&bar[XB_TOP], 1u);
            const unsigned tg = og / nx;
            if (og + 1u == (tg + 1u) * nx) xb_add(&bar[XB_TOPGEN], 1u);
            else XB_SPIN(xb_ld(&bar[XB_TOPGEN]) == tg, bar);
            __builtin_amdgcn_fence(__ATOMIC_ACQUIRE, "agent");
            xb_add(&bar[XB_XGEN(b.x)], 1u);
            asm volatile("s_waitcnt vmcnt(0)" ::: "memory");
        } else {
            XB_SPIN(xb_ld(&bar[XB_XGEN(b.x)]) == gen, bar);
            __builtin_amdgcn_fence(__ATOMIC_ACQUIRE, "agent");
            asm volatile("s_waitcnt vmcnt(0)" ::: "memory");
        }
    }
    __syncthreads();
}


struct Args { const float* in[27]; float* out; unsigned char* ws; int ph_lo, ph_hi; };

struct Frame {
    LAS unsigned char* lds;
    int tid, lane, wave, vcu, G;
    unsigned char* ws;
};
__device__ __forceinline__ void frame_refresh(Frame& F) { int t = threadIdx.x; asm volatile("" : "+v"(t)); F.tid = t; F.lane = t & 63; F.wave = __builtin_amdgcn_readfirstlane(t >> 6); }

struct AttnOrder {
    static constexpr bool GATHER = false;
    int G, c, l, mode;
    __device__ bool next(int i, pg8::Unit& u) const {
        const int L = i * G + c; if (L >= 256) return false;
        const int xcd = L & 7, j = L >> 3, b = xcd >> 1, idx = (xcd & 1) * 32 + j;
        u.pm = b * 16 + (idx >> 2); u.pn = idx & 3; u.e = b; u.rows = 256; return true;
    }
    __device__ size_t a_off(const pg8::Unit& u) const { return ((size_t)u.pm * 256 * DM + (size_t)u.pn * XHD) * 2; }
    __device__ size_t b_off(const pg8::Unit& u) const {
        return mode == 0 ? ((size_t)(u.e * MEM) * (DEPTH * DM) + (size_t)l * DM + (size_t)u.pn * XHD) * 2
                         : ((size_t)(l * DM + u.pn * XHD) * NMEM + (size_t)u.e * MEM) * 2; }
    __device__ int a_row(const pg8::Unit&, int) const { return 0; }
};
template <bool GATHER_> struct MoeOrder {
    static constexpr bool GATHER = GATHER_;
    int G, c, NT; const LAS int* tab; const LAS int* cnt; const int* list; size_t bstride_e; int ldb;
    __device__ bool next(int i, pg8::Unit& u) const {
        const int L = i * G + c; const int total = __builtin_amdgcn_readfirstlane(tab[NEXP]) * NT; if (L >= total) return false;
        const int T = L / NT; int e = 0;
        for (int k = 1; k < NEXP; ++k) { if (__builtin_amdgcn_readfirstlane(tab[k]) <= T) e = k; }
        u.e = e; u.pm = T - __builtin_amdgcn_readfirstlane(tab[e]); u.pn = L - T * NT;
        const int left = __builtin_amdgcn_readfirstlane(cnt[e]) - u.pm * 256; u.rows = left < 256 ? left : 256; return true;
    }
    __device__ size_t a_off(const pg8::Unit& u) const { return GATHER ? (size_t)0 : (size_t)(tab[u.e] + u.pm) * 256 * DEXP * 2; }
    __device__ size_t b_off(const pg8::Unit& u) const { return (size_t)u.e * bstride_e + (size_t)u.pn * 256 * ldb * 2; }
    __device__ int a_row(const pg8::Unit& u, int r) const { const int rr = r < u.rows ? r : u.rows - 1; return list[(size_t)u.e * LIST_CAP + u.pm * 256 + rr] >> 1; }
};
__device__ __forceinline__ void moe_tables(Frame& F, const unsigned* cntg) {
    frame_refresh(F);
    LAS int* tab = (LAS int*)(F.lds + TAB_OFF); LAS int* cl = tab + 40;
    if (F.tid < 64) { const int c = F.tid < NEXP ? (int)cntg[F.tid] : 0; int tl = (c + 255) >> 8; int inc = tl;
#pragma unroll
        for (int o = 1; o < 32; o <<= 1) { const int t = __shfl_up(inc, o); if (F.lane >= o) inc += t; }
        if (F.tid < NEXP) { tab[F.tid] = inc - tl; cl[F.tid] = c; } if (F.tid == NEXP - 1) tab[NEXP] = inc; }
    LDS_WAIT(); __syncthreads();
}

__device__ __forceinline__ void tr_store(LAS float* scr, bf16* dst, int ldd, int drow0, int k0, int lane) {
    LDS_WAIT(); asm volatile("" ::: "memory");
    const int c = lane & 7;
#pragma unroll
    for (int j = 0; j < 4; ++j) { const int n = (lane >> 3) + 8 * j; const LAS float* s = scr + (8 * c) * 33 + n;
        v4u o; o.x = pk2(s[0 * 33], s[1 * 33]); o.y = pk2(s[2 * 33], s[3 * 33]); o.z = pk2(s[4 * 33], s[5 * 33]); o.w = pk2(s[6 * 33], s[7 * 33]);
        *(GAS v4u*)(dst + (size_t)(drow0 + n) * ldd + k0 + 8 * c) = o; }
    LDS_WAIT(); asm volatile("" ::: "memory");
}
__device__ __forceinline__ void tr_item(const float* src, int lds_, int k0, int n0, bf16* dst, int ldd, int drow0, LAS float* scr, int lane) {
    float v[32];
#pragma unroll
    for (int i = 0; i < 32; ++i) { const int kk = 2 * i + (lane >> 5); v[i] = src[(size_t)(k0 + kk) * lds_ + n0 + (lane & 31)]; }
#pragma unroll
    for (int i = 0; i < 32; ++i) { const int kk = 2 * i + (lane >> 5); scr[kk * 33 + (lane & 31)] = v[i]; }
    tr_store(scr, dst, ldd, drow0, k0, lane);
}
__device__ __forceinline__ void fold_item(const float* w_in, const float* w_pool, const float* scale, int k0, int n0, bf16* dst, LAS float* scr, int lane) {
    const int g = n0 >> 7, nn = (n0 & 127) + (lane & 31), kh = lane >> 5;
    float acc[32];
#pragma unroll
    for (int j = 0; j < 32; ++j) acc[j] = 0.f;
    const float* wp = w_pool + (size_t)g * 128 * 128 + nn;
    const float* wi = w_in + (size_t)(k0 + kh) * DIN_E + g * 128;
    for (int c = 0; c < 128; ++c) { const float p = wp[(size_t)c * 128];
#pragma unroll
        for (int j = 0; j < 32; ++j) acc[j] += wi[(size_t)(2 * j) * DIN_E + c] * p; }
    const float sc = scale[n0 + (lane & 31)];
#pragma unroll
    for (int j = 0; j < 32; ++j) scr[(2 * j + kh) * 33 + (lane & 31)] = acc[j] * sc;
    tr_store(scr, dst, DM, n0, k0, lane);
}
__device__ __forceinline__ void cvt_rows(const float* src, bf16* dst, size_t n8, size_t gtid, size_t nthr) {
    for (size_t i = gtid; i < n8; i += nthr) { const f32x4 a = *(const GAS f32x4*)(src + i * 8), b = *(const GAS f32x4*)(src + i * 8 + 4);
        v4u o; o.x = pk2(a.x, a.y); o.y = pk2(a.z, a.w); o.z = pk2(b.x, b.y); o.w = pk2(b.z, b.w); *(GAS v4u*)(dst + i * 8) = o; }
}
__device__ __forceinline__ void prep_phase(Frame& F, const Args& A) {
    frame_refresh(F);
    LAS float* scr = (LAS float*)(F.lds + F.wave * 16384);
    const int gw = F.vcu * NWAVES + F.wave, NGW = F.G * NWAVES, lane = F.lane;
    bf16* W13 = (bf16*)(F.ws + WS_W13); bf16* W2T = (bf16*)(F.ws + WS_W2);
    constexpr int I_W1 = DEPTH * NEXP * 256, I_W2 = DEPTH * NEXP * 256, I_SQ = 20 * 512, I_EIN = 2 * 16 * 32, I_OIN = 2 * 16 * 96, I_FOLD = 2 * 256;
    constexpr int NITEMS = 2 * I_W1 + I_W2 + I_SQ + I_EIN + I_OIN + I_FOLD;
    for (int it = gw; it < NITEMS; it += NGW) {
        int r = it;
        if (r < 2 * I_W1) { const int which = r >= I_W1; r -= which * I_W1; const int mat = r >> 8, rem = r & 255, kb = rem >> 4, nb = rem & 15, n0 = nb * 32;
            tr_item((which ? A.in[25] : A.in[24]) + (size_t)mat * DM * DEXP, DEXP, kb * 64, n0, W13 + (size_t)mat * DM * DM, DM, (n0 >> 7) * 256 + which * 128 + (n0 & 127), scr, lane); continue; }
        r -= 2 * I_W1;
        if (r < I_W2) { const int mat = r >> 8, rem = r & 255, kb = rem >> 5, nb = rem & 31;
            tr_item(A.in[26] + (size_t)mat * DEXP * DM, DM, kb * 64, nb * 32, W2T + (size_t)mat * DM * DEXP, DEXP, nb * 32, scr, lane); continue; }
        r -= I_W2;
        if (r < I_SQ) { const int mat = r >> 9, rem = r & 511, kb = rem >> 5, nb = rem & 31; const float* src; bf16* dst;
            if (mat < 2) { src = A.in[9] + (size_t)mat * DM * DM; dst = (bf16*)(F.ws + WS_W_EOUT) + (size_t)mat * DM * DM; }
            else if (mat < 4) { src = A.in[13] + (size_t)(mat - 2) * DM * DM; dst = (bf16*)(F.ws + WS_W_OOUT) + (size_t)(mat - 2) * DM * DM; }
            else if (mat < 8) { src = A.in[14] + (size_t)(mat - 4) * DM * DM; dst = (bf16*)(F.ws + WS_WQ) + (size_t)(mat - 4) * DM * DM; }
            else if (mat < 12) { src = A.in[17] + (size_t)(mat - 8) * DM * DM; dst = (bf16*)(F.ws + WS_WO) + (size_t)(mat - 8) * DM * DM; }
            else if (mat < 16) { src = A.in[15] + (size_t)(mat - 12) * DM * DM; dst = (bf16*)(F.ws + WS_WK) + (size_t)(mat - 12) * DM * DM; }
            else { src = A.in[16] + (size_t)(mat - 16) * DM * DM; dst = (bf16*)(F.ws + WS_WV) + (size_t)(mat - 16) * DM * DM; }
            tr_item(src, DM, kb * 64, nb * 32, dst, DM, nb * 32, scr, lane); continue; }
        r -= I_SQ;
        if (r < I_EIN) { const int i = r >> 9, rem = r & 511, kb = rem >> 5, nb = rem & 31, n0 = 512 + nb * 32;
            tr_item(A.in[2] + (size_t)i * DM * DIN_E, DIN_E, kb * 64, n0, (bf16*)(F.ws + WS_W_EIN) + (size_t)i * DIN_E * DM, DM, n0, scr, lane); continue; }
        r -= I_EIN;
        if (r < I_OIN) { const int i = r / 1536, rem = r % 1536, kb = rem / 96, nb = rem % 96, n0 = nb * 32; int drow;
            if (n0 < DM) drow = 2048 + n0; else if (n0 < 2 * DM) { const int ch = n0 - DM; drow = (ch >> 7) * 256 + (ch & 127); } else { const int ch = n0 - 2 * DM; drow = (ch >> 7) * 256 + 128 + (ch & 127); }
            tr_item(A.in[10] + (size_t)i * DM * DIN_O, DIN_O, kb * 64, n0, (bf16*)(F.ws + WS_W_OIN) + (size_t)i * DIN_O * DM, DM, drow, scr, lane); continue; }
        r -= I_OIN;
        { const int i = r >> 8, rem = r & 255, kb = rem >> 4, nb = rem & 15;
            fold_item(A.in[2] + (size_t)i * DM * DIN_E, A.in[3] + (size_t)i * 4 * 128 * 128, A.in[4] + (size_t)i * 512, kb * 64, nb * 32, (bf16*)(F.ws + WS_W_EIN) + (size_t)i * DIN_E * DM, scr, lane); }
    }
    const size_t gtid = (size_t)F.vcu * (NWAVES * 64) + F.tid, nthr = (size_t)F.G * NWAVES * 64;
    cvt_rows(A.in[0], (bf16*)(F.ws + WS_XB), (size_t)NTOK * DM / 8, gtid, nthr);
    cvt_rows(A.in[1], (bf16*)(F.ws + WS_MEMB), (size_t)NMEM * DM / 8, gtid, nthr);
    bf16* wsb = (bf16*)(F.ws + WS_WSB);
    for (size_t i = gtid; i < (size_t)2 * 4 * 128 * 128; i += nthr) { const int jj = (int)(i & 127), ii = (int)((i >> 7) & 127); wsb[i] = (jj <= ii) ? (bf16)f2bf(A.in[7][i]) : (bf16)0; }
}

__device__ __forceinline__ float wsum(float v) {
#pragma unroll
    for (int o = 1; o < 64; o <<= 1) v += __shfl_xor(v, o);
    return v;
}
template <int MODE, bool ROUTER>
__device__ __forceinline__ void ln_phase(Frame& F, const float* Y, const bf16* OUT2, const float* gam, const float* bet, float* X, bf16* XB, float* OUT,
                                         const float* wrg, const float* brg, const float* wre, const float* bre, unsigned* cnt, int* list, float* gate) {
    frame_refresh(F);
    const int gw = F.vcu * NWAVES + F.wave, NGW = F.G * NWAVES, lane = F.lane;
    f32x4 gv[4], bv[4];
#pragma unroll
    for (int j = 0; j < 4; ++j) { gv[j] = *(const GAS f32x4*)(gam + 4 * lane + 256 * j); bv[j] = *(const GAS f32x4*)(bet + 4 * lane + 256 * j); }
    int myE = 0, mySlot = 0, k = 0;
    for (int row = gw; row < NTOK; row += NGW, ++k) {
        f32x4 v[4]; float s = 0.f;
#pragma unroll
        for (int j = 0; j < 4; ++j) {
            if (MODE == 0) v[j] = *(const GAS f32x4*)(Y + (size_t)row * DM + 4 * lane + 256 * j);
            else { const f32x4 xv = *(const GAS f32x4*)(X + (size_t)row * DM + 4 * lane + 256 * j);
                const v2u a = *(const GAS v2u*)(OUT2 + (size_t)(2 * row) * DM + 4 * lane + 256 * j), b = *(const GAS v2u*)(OUT2 + (size_t)(2 * row + 1) * DM + 4 * lane + 256 * j);
                v[j].x = ALPHA * xv.x + bflo(a.x) + bflo(b.x); v[j].y = ALPHA * xv.y + bfhi(a.x) + bfhi(b.x); v[j].z = ALPHA * xv.z + bflo(a.y) + bflo(b.y); v[j].w = ALPHA * xv.w + bfhi(a.y) + bfhi(b.y); }
            s += (v[j].x + v[j].y) + (v[j].z + v[j].w); }
        const float mean = wsum(s) * (1.f / DM); float s2 = 0.f;
#pragma unroll
        for (int j = 0; j < 4; ++j) { v[j] = v[j] - mean; s2 += (v[j].x * v[j].x + v[j].y * v[j].y) + (v[j].z * v[j].z + v[j].w * v[j].w); }
        const float rstd = 1.f / sqrtf(wsum(s2) * (1.f / DM) + LN_EPS);
#pragma unroll
        for (int j = 0; j < 4; ++j) { v[j] = v[j] * rstd * gv[j] + bv[j];
            *(GAS f32x4*)(X + (size_t)row * DM + 4 * lane + 256 * j) = v[j];
            if (OUT) *(GAS f32x4*)(OUT + (size_t)row * DM + 4 * lane + 256 * j) = v[j];
            v2u w; w.x = pk2(v[j].x, v[j].y); w.y = pk2(v[j].z, v[j].w); *(GAS v2u*)(XB + (size_t)row * DM + 4 * lane + 256 * j) = w; }
        if constexpr (ROUTER) {
            float g0 = 0.f, g1 = 0.f, g2 = 0.f, g3 = 0.f;
#pragma unroll 1
            for (int j = 0; j < 4; ++j)
#pragma unroll
                for (int q = 0; q < 4; ++q) { const f32x4 w = *(const GAS f32x4*)(wrg + (size_t)(4 * lane + 256 * j + q) * 4); const float xv = v[j][q]; g0 += xv * w.x; g1 += xv * w.y; g2 += xv * w.z; g3 += xv * w.w; }
            g0 = wsum(g0) + brg[0]; g1 = wsum(g1) + brg[1]; g2 = wsum(g2) + brg[2]; g3 = wsum(g3) + brg[3];
            int gs = 0; float gm = g0;
            if (g1 > gm) { gm = g1; gs = 1; } if (g2 > gm) { gm = g2; gs = 2; } if (g3 > gm) { gm = g3; gs = 3; }
            gs = __builtin_amdgcn_readfirstlane(gs);
            const float gate_g = 1.f / (__expf(g0 - gm) + __expf(g1 - gm) + __expf(g2 - gm) + __expf(g3 - gm));
            const float* we = wre + (size_t)gs * DM * 8;
            float e0 = 0.f, e1 = 0.f, e2 = 0.f, e3 = 0.f, e4 = 0.f, e5 = 0.f, e6 = 0.f, e7 = 0.f;
#pragma unroll 1
            for (int j = 0; j < 4; ++j)
#pragma unroll
                for (int q = 0; q < 4; ++q) { const float* wp = we + (size_t)(4 * lane + 256 * j + q) * 8; const f32x4 wa = *(const GAS f32x4*)wp, wb = *(const GAS f32x4*)(wp + 4); const float xv = v[j][q];
                    e0 += xv * wa.x; e1 += xv * wa.y; e2 += xv * wa.z; e3 += xv * wa.w; e4 += xv * wb.x; e5 += xv * wb.y; e6 += xv * wb.z; e7 += xv * wb.w; }
            const float* be = bre + gs * 8;
            e0 = wsum(e0) + be[0]; e1 = wsum(e1) + be[1]; e2 = wsum(e2) + be[2]; e3 = wsum(e3) + be[3]; e4 = wsum(e4) + be[4]; e5 = wsum(e5) + be[5]; e6 = wsum(e6) + be[6]; e7 = wsum(e7) + be[7];
            int i1 = 0; float v1 = e0;
            if (e1 > v1) { v1 = e1; i1 = 1; } if (e2 > v1) { v1 = e2; i1 = 2; } if (e3 > v1) { v1 = e3; i1 = 3; }
            if (e4 > v1) { v1 = e4; i1 = 4; } if (e5 > v1) { v1 = e5; i1 = 5; } if (e6 > v1) { v1 = e6; i1 = 6; } if (e7 > v1) { v1 = e7; i1 = 7; }
            int i2 = -1; float v2 = -3.0e38f;
            if (i1 != 0 && e0 > v2) { v2 = e0; i2 = 0; } if (i1 != 1 && e1 > v2) { v2 = e1; i2 = 1; } if (i1 != 2 && e2 > v2) { v2 = e2; i2 = 2; } if (i1 != 3 && e3 > v2) { v2 = e3; i2 = 3; }
            if (i1 != 4 && e4 > v2) { v2 = e4; i2 = 4; } if (i1 != 5 && e5 > v2) { v2 = e5; i2 = 5; } if (i1 != 6 && e6 > v2) { v2 = e6; i2 = 6; } if (i1 != 7 && e7 > v2) { v2 = e7; i2 = 7; }
            const float ex = __expf(v2 - v1);
            if (lane == 0) { gate[2 * row] = gate_g / (1.f + ex); gate[2 * row + 1] = gate_g * ex / (1.f + ex); }
            const int kk = k & 31;
            if (lane == 2 * kk) { myE = gs * 8 + i1; mySlot = 2 * row; }
            if (lane == 2 * kk + 1) { myE = gs * 8 + i2; mySlot = 2 * row + 1; }
            if (kk == 31 || row + NGW >= NTOK) {
                if (lane < 2 * (kk + 1)) { const unsigned p = atomicAdd(cnt + myE, 1u); list[(size_t)myE * LIST_CAP + p] = mySlot; }
            }
        }
    }
}
__device__ __forceinline__ void emix_phase(Frame& F, const bf16* H, bf16* CAT, const bf16* WSB, const float* lng, const float* lnb, const float* bsp) {
    frame_refresh(F);
    const int lane = F.lane, w = F.wave, fr = lane & 15, fq = lane >> 4;
    LAS unsigned char* BtL = F.lds;
    for (int u = blockIdx.x; u < 1024; u += F.G) {
        if (u < 512) {
            const int chunk = u >> 2, h = u & 3, tb = chunk * CHUNK;
            const int hl = lane - h * 16;
            float gch[8], bch[8];
            if (hl >= 0 && hl < 16) {
#pragma unroll
                for (int j = 0; j < 8; ++j) { gch[j] = lng[h * 128 + hl * 8 + j]; bch[j] = lnb[h * 128 + hl * 8 + j]; } }
            for (int rr = 0; rr < 16; ++rr) { const int r = w * 16 + rr;
                const v4u raw = *(const GAS v4u*)(H + (size_t)(tb + r) * DIN_E + 1024 + lane * 8);
                float x[8] = {bflo(raw.x), bfhi(raw.x), bflo(raw.y), bfhi(raw.y), bflo(raw.z), bfhi(raw.z), bflo(raw.w), bfhi(raw.w)};
                float s = 0.f;
#pragma unroll
                for (int j = 0; j < 8; ++j) s += x[j];
                const float mean = wsum(s) * (1.f / 512.f); float q = 0.f;
#pragma unroll
                for (int j = 0; j < 8; ++j) { x[j] -= mean; q += x[j] * x[j]; }
                const float rstd = 1.f / sqrtf(wsum(q) * (1.f / 512.f) + LN_EPS);
                if (hl >= 0 && hl < 16) {
#pragma unroll
                    for (int j = 0; j < 8; ++j) *(LAS bf16*)(BtL + (hl * 8 + j) * 272 + r * 2) = (bf16)f2bf(x[j] * rstd * gch[j] + bch[j]); }
            }
            LDS_WAIT(); __syncthreads();
            f32x4 acc[8];
#pragma unroll
            for (int nb = 0; nb < 8; ++nb) acc[nb] = (f32x4){0.f, 0.f, 0.f, 0.f};
            const bf16* wsrow = WSB + ((size_t)h * CHUNK + 16 * w + fr) * CHUNK;
#pragma unroll
            for (int s = 0; s < 4; ++s) { if (32 * s <= 16 * w + 15) {
                const bf16x8v af = *(const GAS bf16x8v*)(wsrow + 32 * s + 8 * fq);
#pragma unroll
                for (int nb = 0; nb < 8; ++nb) { const bf16x8v bfr = *(const LAS bf16x8v*)(BtL + (16 * nb + fr) * 272 + (32 * s + 8 * fq) * 2);
                    acc[nb] = __builtin_amdgcn_mfma_f32_16x16x32_bf16(bfr, af, acc[nb], 0, 0, 0); } } }
            const int t = tb + 16 * w + fr; const float bias = bsp[h * CHUNK + 16 * w + fr];
#pragma unroll
            for (int nb = 0; nb < 8; ++nb) { const int c = h * 128 + 16 * nb + 4 * fq;
                const v2u uv = *(const GAS v2u*)(H + (size_t)t * DIN_E + 512 + c);
                v2u o; o.x = pk2(bflo(uv.x) * (acc[nb][0] + bias), bfhi(uv.x) * (acc[nb][1] + bias)); o.y = pk2(bflo(uv.y) * (acc[nb][2] + bias), bfhi(uv.y) * (acc[nb][3] + bias));
                *(GAS v2u*)(CAT + (size_t)t * DM + 512 + c) = o; }
            __syncthreads();
        } else {
            const int uu = u - 512, chunk = uu >> 2, g = uu & 3, win = 2 << g, tb = chunk * CHUNK + 16 * w, s0 = tb & (SEQ - 1);
            const bf16* col = H + g * 128 + 2 * lane;
            float sx = 0.f, sy = 0.f;
            for (int j = 1; j < win; ++j) { if (s0 - j >= 0) { const unsigned a = *(const GAS unsigned*)(col + (size_t)(tb - j) * DIN_E); sx += bflo(a); sy += bfhi(a); } }
            for (int rr = 0; rr < 16; ++rr) { const int t = tb + rr, s = s0 + rr;
                const unsigned a = *(const GAS unsigned*)(col + (size_t)t * DIN_E); const float ax = bflo(a), ay = bfhi(a);
                sx += ax; sy += ay;
                const float inv = 1.f / (float)(s + 1 < win ? s + 1 : win);
                *(GAS unsigned*)(CAT + (size_t)t * DM + g * 128 + 2 * lane) = pk2(sx * inv - ax, sy * inv - ay);
                if (s - win + 1 >= 0) { const unsigned o = *(const GAS unsigned*)(col + (size_t)(t - win + 1) * DIN_E); sx -= bflo(o); sy -= bfhi(o); } }
        }
    }
}
__device__ __forceinline__ void conv_phase(Frame& F, const bf16* ZC, const bf16* BG, bf16* CAT, const float* cw, const float* cb) {
    frame_refresh(F);
    const size_t gtid = (size_t)F.vcu * (NWAVES * 64) + F.tid, nthr = (size_t)F.G * NWAVES * 64;
    for (size_t it = gtid; it < (size_t)NTOK * 128; it += nthr) { const int t = (int)(it >> 7), c8 = (int)(it & 127) * 8, s = t & (SEQ - 1);
        const size_t o = (size_t)t * DM + c8;
        const v4u z0 = *(const GAS v4u*)(ZC + o), bg = *(const GAS v4u*)(BG + o);
        v4u z1 = {0u, 0u, 0u, 0u}, z2 = {0u, 0u, 0u, 0u};
        if (s >= 1) z1 = *(const GAS v4u*)(ZC + o - DM);
        if (s >= 2) z2 = *(const GAS v4u*)(ZC + o - 2 * DM);
        float wv[24], bb[8];
#pragma unroll
        for (int j = 0; j < 6; ++j) { const f32x4 q = *(const GAS f32x4*)(cw + (size_t)c8 * 3 + 4 * j); wv[4 * j] = q.x; wv[4 * j + 1] = q.y; wv[4 * j + 2] = q.z; wv[4 * j + 3] = q.w; }
#pragma unroll
        for (int j = 0; j < 2; ++j) { const f32x4 q = *(const GAS f32x4*)(cb + c8 + 4 * j); bb[4 * j] = q.x; bb[4 * j + 1] = q.y; bb[4 * j + 2] = q.z; bb[4 * j + 3] = q.w; }
        const unsigned z0w[4] = {z0.x, z0.y, z0.z, z0.w}, z1w[4] = {z1.x, z1.y, z1.z, z1.w}, z2w[4] = {z2.x, z2.y, z2.z, z2.w}, bgw[4] = {bg.x, bg.y, bg.z, bg.w};
        unsigned ow[4];
#pragma unroll
        for (int p = 0; p < 4; ++p) {
            const float c0 = bb[2 * p] + bflo(z2w[p]) * wv[6 * p] + bflo(z1w[p]) * wv[6 * p + 1] + bflo(z0w[p]) * wv[6 * p + 2];
            const float c1 = bb[2 * p + 1] + bfhi(z2w[p]) * wv[6 * p + 3] + bfhi(z1w[p]) * wv[6 * p + 4] + bfhi(z0w[p]) * wv[6 * p + 5];
            ow[p] = pk2(bflo(bgw[p]) * c0, bfhi(bgw[p]) * c1); }
        v4u ov; ov.x = ow[0]; ov.y = ow[1]; ov.z = ow[2]; ov.w = ow[3];
        *(GAS v4u*)(CAT + o) = ov; }
}

__global__ void __launch_bounds__(NWAVES * 64, 2) mega(Args args) {
    extern __shared__ __attribute__((aligned(16))) unsigned char lds_raw[];
    Frame F;
    F.lds = (LAS unsigned char*)lds_raw;
    F.tid = threadIdx.x; F.lane = F.tid & 63; F.wave = __builtin_amdgcn_readfirstlane(F.tid >> 6);
    F.G = gridDim.x; { const int bx = blockIdx.x; F.vcu = (F.G % 8 == 0) ? (bx % 8) * (F.G / 8) + bx / 8 : bx; }
    F.ws = args.ws;
    unsigned char* ws = args.ws;
    unsigned* ctl = (unsigned*)(ws + WS_CTL);
    for (int u = F.tid; u < (LDS_BYTES - LDSCTL_OFF) / 4; u += NWAVES * 64) ((LAS unsigned*)(F.lds + LDSCTL_OFF))[u] = 0u;
    __syncthreads();
    const int lo = args.ph_lo, hi = args.ph_hi;
    XcdBarrier bar; bar.bar = ctl + CW_BAR; bar.x = 0; bar.st = nullptr;
    if (hi - lo > 1) bar = xcd_barrier_post(ctl + CW_BAR, (volatile LAS unsigned*)(F.lds + MISC_OFF) + 8);
#ifndef PHMASK
#define PHMASK 0x3fff
#endif
#define PHEN(k) ((PHMASK >> ((k) < 2 ? 12 + (k) : ((k) - 2) % NPL)) & 1)
#define RUN(k) (PHEN(k) && lo <= (k) && (k) < hi)
#define SEAM(k) do { if ((k) + 1 < hi) xcd_barrier(bar); } while (0)
    float* X = (float*)(ws + WS_X); bf16* XB = (bf16*)(ws + WS_XB); float* Y = (float*)(ws + WS_Y); bf16* CAT = (bf16*)(ws + WS_CAT);
    bf16* KALL = (bf16*)(ws + WS_KV); bf16* VTALL = KALL + (size_t)NMEM * DEPTH * DM; bf16* MEMB = (bf16*)(ws + WS_MEMB);
    int* LIST = (int*)(ws + WS_LIST); float* GATE = (float*)(ws + WS_GATE);
    unsigned char* SCR = ws + WS_SCR;
    LAS unsigned char* ring = F.lds;
    const int cblk = (int)blockIdx.x;

    if (RUN(0)) { prep_phase(F, args); SEAM(0); }
    if (RUN(1)) {
        { pg8::Gemm g{MEMB, (const bf16*)(ws + WS_WK), DM, DM, DM}; pg8::DenseOrder S; S.init(NMEM, DEPTH * DM, F.G, cblk, DM, DM);
          pg8::EpiBf16 E{KALL, DEPTH * DM, 1 << 30}; pg8::gemm_phase<pg8::EpiBf16, pg8::DenseOrder, false>(ring, g, S, E); }
        { pg8::Gemm g{(const bf16*)(ws + WS_WV), MEMB, DM, DM, DM}; pg8::DenseOrder S; S.init(DEPTH * DM, NMEM, F.G, (cblk + F.G / 2) % F.G, DM, DM);
          pg8::EpiBf16 E{VTALL, NMEM, 1 << 30}; pg8::gemm_phase<pg8::EpiBf16, pg8::DenseOrder, false>(ring, g, S, E); }
        SEAM(1);
    }
    for (int l = 0; l < DEPTH; ++l) {
        const int base = 2 + l * NPL, i = l >> 1;
        if (base + NPL <= lo || base >= hi) continue;
        const float* ln_g = args.in[18] + (size_t)l * 3 * DM; const float* ln_b = args.in[19] + (size_t)l * 3 * DM;
        if (RUN(base + 0)) {
            if ((l & 1) == 0) { pg8::Gemm g{XB, (const bf16*)(ws + WS_W_EIN) + (size_t)i * DIN_E * DM, DM, DM, DM}; pg8::DenseOrder S; S.init(NTOK, DIN_E, F.G, cblk, DM, DM);
                pg8::EpiBf16 E{(bf16*)SCR, DIN_E, 2}; pg8::gemm_phase<pg8::EpiBf16, pg8::DenseOrder, true>(ring, g, S, E); }
            else { pg8::Gemm g{XB, (const bf16*)(ws + WS_W_OIN) + (size_t)i * DIN_O * DM, DM, DM, DM}; pg8::DenseOrder S; S.init(NTOK, DIN_O, F.G, cblk, DM, DM);
                pg8::EpiPair<0> E{(bf16*)SCR, (bf16*)(SCR + 32 * MiB), DM, 8, DM}; pg8::gemm_phase<pg8::EpiPair<0>, pg8::DenseOrder, true>(ring, g, S, E); }
            SEAM(base + 0);
        }
        if (RUN(base + 1)) {
            if ((l & 1) == 0) emix_phase(F, (const bf16*)SCR, CAT, (const bf16*)(ws + WS_WSB) + (size_t)i * 4 * CHUNK * CHUNK, args.in[5] + (size_t)i * 512, args.in[6] + (size_t)i * 512, args.in[8] + (size_t)i * 4 * CHUNK);
            else conv_phase(F, (const bf16*)SCR, (const bf16*)(SCR + 32 * MiB), CAT, args.in[11] + (size_t)i * DM * 3, args.in[12] + (size_t)i * DM);
            SEAM(base + 1);
        }
        if (RUN(base + 2)) {
            const bf16* W = (l & 1) ? (const bf16*)(ws + WS_W_OOUT) + (size_t)i * DM * DM : (const bf16*)(ws + WS_W_EOUT) + (size_t)i * DM * DM;
            pg8::Gemm g{CAT, W, DM, DM, DM}; pg8::DenseOrder S; S.init(NTOK, DM, F.G, cblk, DM, DM);
            pg8::EpiResid E{l == 0 ? args.in[0] : X, Y, DM, ALPHA}; pg8::gemm_phase<pg8::EpiResid, pg8::DenseOrder, false>(ring, g, S, E);
            SEAM(base + 2);
        }
        if (RUN(base + 3)) { ln_phase<0, false>(F, Y, nullptr, ln_g, ln_b, X, XB, nullptr, nullptr, nullptr, nullptr, nullptr, nullptr, nullptr, nullptr); SEAM(base + 3); }
        if (RUN(base + 4)) {
            pg8::Gemm g{XB, (const bf16*)(ws + WS_WQ) + (size_t)l * DM * DM, DM, DM, DM}; pg8::DenseOrder S; S.init(NTOK, DM, F.G, cblk, DM, DM);
            pg8::EpiBf16 E{(bf16*)SCR, DM, 1 << 30}; pg8::gemm_phase<pg8::EpiBf16, pg8::DenseOrder, false>(ring, g, S, E);
            SEAM(base + 4);
        }
        if (RUN(base + 5)) {
            pg8::Gemm g{(const bf16*)SCR, KALL, DM, DEPTH * DM, XHD}; AttnOrder S{F.G, cblk, l, 0};
            pg8::EpiSoftmax E{(bf16*)(SCR + 64 * MiB), DM, 0.0625f * 1.4426950408889634f}; pg8::gemm_phase<pg8::EpiSoftmax, AttnOrder, false>(ring, g, S, E);
            SEAM(base + 5);
        }
        if (RUN(base + 6)) {
            pg8::Gemm g{(const bf16*)(SCR + 64 * MiB), VTALL, DM, NMEM, XHD}; AttnOrder S{F.G, cblk, l, 1};
            pg8::EpiBf16 E{(bf16*)(SCR + 32 * MiB), DM, 1 << 30}; pg8::gemm_phase<pg8::EpiBf16, AttnOrder, false>(ring, g, S, E);
            SEAM(base + 6);
        }
        if (RUN(base + 7)) {
            pg8::Gemm g{(const bf16*)(SCR + 32 * MiB), (const bf16*)(ws + WS_WO) + (size_t)l * DM * DM, DM, DM, DM}; pg8::DenseOrder S; S.init(NTOK, DM, F.G, cblk, DM, DM);
            pg8::EpiResid E{X, Y, DM, ALPHA}; pg8::gemm_phase<pg8::EpiResid, pg8::DenseOrder, false>(ring, g, S, E);
            SEAM(base + 7);
        }
        unsigned* cnt = ctl + CW_CNT + l * NEXP;
        if (RUN(base + 8)) {
            ln_phase<0, true>(F, Y, nullptr, ln_g + DM, ln_b + DM, X, XB, nullptr, args.in[20] + (size_t)l * DM * 4, args.in[21] + (size_t)l * 4, args.in[22] + (size_t)l * 4 * DM * 8, args.in[23] + (size_t)l * 32, cnt, LIST, GATE);
            SEAM(base + 8);
        }
        if (RUN(base + 9)) {
            moe_tables(F, cnt);
            const LAS int* tab = (const LAS int*)(F.lds + TAB_OFF);
            pg8::Gemm g{XB, (const bf16*)(ws + WS_W13) + (size_t)l * NEXP * DM * DM, DM, DM, DM};
            MoeOrder<true> S{F.G, cblk, 4, tab, tab + 40, LIST, (size_t)DM * DM * 2, DM};
            pg8::EpiMoe1 E{(bf16*)SCR, tab}; pg8::gemm_phase<pg8::EpiMoe1, MoeOrder<true>, true>(ring, g, S, E);
            SEAM(base + 9);
        }
        if (RUN(base + 10)) {
            moe_tables(F, cnt);
            const LAS int* tab = (const LAS int*)(F.lds + TAB_OFF);
            pg8::Gemm g{(const bf16*)SCR, (const bf16*)(ws + WS_W2) + (size_t)l * NEXP * DM * DEXP, DEXP, DEXP, DEXP};
            MoeOrder<false> S{F.G, cblk, 4, tab, tab + 40, LIST, (size_t)DM * DEXP * 2, DEXP};
            pg8::EpiMoe2 E{(bf16*)(SCR + 96 * MiB), LIST, GATE, LIST_CAP}; pg8::gemm_phase<pg8::EpiMoe2, MoeOrder<false>, true>(ring, g, S, E);
            SEAM(base + 10);
        }
        if (RUN(base + 11)) {
            ln_phase<1, false>(F, nullptr, (const bf16*)(SCR + 96 * MiB), ln_g + 2 * DM, ln_b + 2 * DM, X, XB, l == DEPTH - 1 ? args.out : nullptr, nullptr, nullptr, nullptr, nullptr, nullptr, nullptr, nullptr);
            SEAM(base + 11);
        }
    }
#undef RUN
#undef SEAM
}

#ifndef FAST_MASK
#define FAST_MASK 0x3ff
#endif
template <class P> static void ngemm(P p, int N, int Mmax, int Z, hipStream_t s) { static_assert(sizeof(P) % 8 == 0, "no tail padding"); hipLaunchKernelGGL(k_ngemm<P>, dim3(N / 128, (Mmax + 127) / 128, Z), dim3(256), 0, s, p); }

extern "C" void kernel_launch(void* const* d_in, const int* in_sizes, int n_in, void* d_out, int out_size, void* d_ws, size_t ws_size, hipStream_t stream) {
    static int grid = 0;
    if (grid == 0) {
        if (n_in != 27 || out_size != NTOK * DM || ws_size < WS_END2) { fprintf(stderr, "kernel_launch: unexpected shapes (n_in %d out %d ws %zu need %zu)\n", n_in, out_size, ws_size, (size_t)WS_END2); grid = -1; return; }
        int dev = 0, cus = 0, per_cu = 0;
        if (hipGetDevice(&dev) != hipSuccess || hipDeviceGetAttribute(&cus, hipDeviceAttributeMultiprocessorCount, dev) != hipSuccess) { grid = -1; return; }
        if (hipFuncSetAttribute((const void*)mega, hipFuncAttributeMaxDynamicSharedMemorySize, LDS_BYTES) != hipSuccess) { fprintf(stderr, "kernel_launch: hipFuncSetAttribute failed\n"); grid = -1; return; }
        if (hipOccupancyMaxActiveBlocksPerMultiprocessor(&per_cu, (const void*)mega, NWAVES * 64, LDS_BYTES) != hipSuccess || per_cu < 1) fprintf(stderr, "kernel_launch: occupancy query reports %d\n", per_cu);
        (void)hipGetLastError();
        grid = cus;
        if (grid != 256) fprintf(stderr, "kernel_launch: %d CUs (built for 256)\n", grid);
    }
    if (grid < 0) return;
    const float* in_x = (const float*)d_in[0]; const float* in_mem = (const float*)d_in[1];
    const float* w_in_even = (const float*)d_in[2]; const float* w_pool = (const float*)d_in[3]; const float* pool_scale = (const float*)d_in[4];
    const float* ln_v_g = (const float*)d_in[5]; const float* ln_v_b = (const float*)d_in[6]; const float* w_spatial = (const float*)d_in[7]; const float* b_spatial = (const float*)d_in[8];
    const float* w_out_even = (const float*)d_in[9]; const float* w_in_odd = (const float*)d_in[10]; const float* conv_w = (const float*)d_in[11]; const float* conv_b = (const float*)d_in[12];
    const float* w_out_odd = (const float*)d_in[13]; const float* wq = (const float*)d_in[14]; const float* wk = (const float*)d_in[15]; const float* wv = (const float*)d_in[16]; const float* wo = (const float*)d_in[17];
    const float* ln_g = (const float*)d_in[18]; const float* ln_b = (const float*)d_in[19]; const float* wr_group = (const float*)d_in[20]; const float* br_group = (const float*)d_in[21];
    const float* wr_expert = (const float*)d_in[22]; const float* br_expert = (const float*)d_in[23]; const float* w1 = (const float*)d_in[24]; const float* w3 = (const float*)d_in[25]; const float* w2 = (const float*)d_in[26];
    char* ws = (char*)d_ws;
    unsigned* ctl = (unsigned*)(ws + WS_CTL);
    float* X = (float*)(ws + WS_X); bf16* XB = (bf16*)(ws + WS_XB); float* Y = (float*)(ws + WS_Y); bf16* CAT = (bf16*)(ws + WS_CAT);
    bf16* KB = (bf16*)(ws + WS_KV); bf16* VTB = KB + (size_t)DEPTH * NMEM * DM; bf16* MEMB = (bf16*)(ws + WS_MEMB);
    int* LIST = (int*)(ws + WS_LIST); float* GATE = (float*)(ws + WS_GATE);
    char* SCR = ws + WS_SCR;
    (void)hipMemsetAsync(ctl, 0, CTL_BYTES, stream);
    Args a{};
    for (int i = 0; i < 27; ++i) a.in[i] = (const float*)d_in[i];
    a.out = (float*)d_out; a.ws = (unsigned char*)d_ws;
    auto phase = [&](int lo, int hi) { a.ph_lo = lo; a.ph_hi = hi; hipLaunchKernelGGL(mega, dim3(grid), dim3(NWAVES * 64), LDS_BYTES, stream, a); };
    constexpr unsigned FM = FAST_MASK;
    if (FM == 0x3ff) { phase(0, NPHASE); return; }
    if (FM & 1) { phase(0, 1); phase(1, 2); hipLaunchKernelGGL(k_cvt, dim3(2048), dim3(256), 0, stream, in_x, X, XB, (size_t)NTOK * DM); }
    else {
        hipLaunchKernelGGL(k_cvt, dim3(2048), dim3(256), 0, stream, in_x, X, XB, (size_t)NTOK * DM);
        hipLaunchKernelGGL(k_cvt, dim3(512), dim3(256), 0, stream, in_mem, (float*)nullptr, MEMB, (size_t)NMEM * DM);
        for (int l = 0; l < DEPTH; ++l) {
            ngemm(PBf16ToBf16{MEMB, wk + (size_t)l * DM * DM, KB + (size_t)l * DM, DM, DM, DM, NMEM, DEPTH * DM, 0}, DM, NMEM, 1, stream);
            ngemm(PBf16ToBf16{MEMB, wv + (size_t)l * DM * DM, VTB + (size_t)l * DM * NMEM, DM, DM, DM, NMEM, NMEM, 1}, DM, NMEM, 1, stream);
        }
    }
    for (int l = 0; l < DEPTH; ++l) {
        const int i = l / 2, base = 2 + l * NPL;
        if (FM & 2) { phase(base + 0, base + 1); phase(base + 1, base + 2); }
        else if (l % 2 == 0) {
            float* Hf = (float*)SCR; float* D = (float*)(SCR + 96 * MiB);
            ngemm(PBf16ToF32{XB, w_in_even + (size_t)i * DM * DIN_E, Hf, DM, DIN_E, DM, NTOK, DIN_E, 0}, DIN_E, NTOK, 1, stream);
            hipLaunchKernelGGL(k_even_pool, dim3(NTOK * 512 / 256), dim3(256), 0, stream, Hf, D);
            ngemm(PPool{D, w_pool + (size_t)i * 4 * 128 * 128, pool_scale + (size_t)i * 512, CAT}, 128, NTOK, 4, stream);
            hipLaunchKernelGGL(k_even_gelu_ln, dim3(NTOK / 4), dim3(256), 0, stream, Hf, ln_v_g + (size_t)i * 512, ln_v_b + (size_t)i * 512);
            hipLaunchKernelGGL(k_even_gate, dim3(NTOK * 512 / 256), dim3(256), 0, stream, Hf, w_spatial + (size_t)i * 4 * 128 * 128, b_spatial + (size_t)i * 4 * 128, CAT);
        } else {
            float* ZC = (float*)SCR; float* BG = (float*)(SCR + 64 * MiB);
            const float* W = w_in_odd + (size_t)i * DM * DIN_O;
            ngemm(PBf16ToF32{XB, W + DM, ZC, DM, DIN_O, DM, NTOK, DM, 0}, DM, NTOK, 1, stream);
            ngemm(PBf16MulF32{XB, W + 2 * DM, ZC, DM, DIN_O, DM, NTOK, DM, 0}, DM, NTOK, 1, stream);
            ngemm(PBf16ToF32{XB, W, BG, DM, DIN_O, DM, NTOK, DM, 0}, DM, NTOK, 1, stream);
            hipLaunchKernelGGL(k_odd_conv, dim3(NTOK * DM / 256), dim3(256), 0, stream, ZC, BG, conv_w + (size_t)i * DM * 3, conv_b + (size_t)i * DM, CAT);
        }
        if (FM & 4) phase(base + 2, base + 3);
        else ngemm(PResid{CAT, (l % 2 ? w_out_odd : w_out_even) + (size_t)i * DM * DM, l == 0 ? in_x : X, Y, DM, DM, DM, NTOK}, DM, NTOK, 1, stream);
        if (FM & 8) phase(base + 3, base + 4);
        else hipLaunchKernelGGL(k_ln, dim3(NTOK / 4), dim3(256), 0, stream, Y, (const float*)nullptr, (const bf16*)nullptr, ln_g + (size_t)(l * 3 + 0) * DM, ln_b + (size_t)(l * 3 + 0) * DM, X, XB, (float*)nullptr);
        bf16* Q = (bf16*)SCR; bf16* O = (bf16*)(SCR + 32 * MiB);
        if (FM & 16) phase(base + 4, base + 5);
        else ngemm(PBf16ToBf16{XB, wq + (size_t)l * DM * DM, Q, DM, DM, DM, NTOK, DM, 0}, DM, NTOK, 1, stream);
        if (FM & 32) { phase(base + 5, base + 6); phase(base + 6, base + 7); }
        else hipLaunchKernelGGL(k_attn, dim3(NTOK, NXH), dim3(256), 0, stream, Q, KB + (size_t)l * DM, DEPTH * DM, VTB + (size_t)l * DM * NMEM, O);
        if (FM & 64) phase(base + 7, base + 8);
        else ngemm(PResid{O, wo + (size_t)l * DM * DM, X, Y, DM, DM, DM, NTOK}, DM, NTOK, 1, stream);
        unsigned* cnt = ctl + CW_CNT + l * NEXP; unsigned* off = ctl + CW_OFF + l * (NEXP + 1);
        if (FM & 128) phase(base + 8, base + 9);
        else {
            hipLaunchKernelGGL(k_ln, dim3(NTOK / 4), dim3(256), 0, stream, Y, (const float*)nullptr, (const bf16*)nullptr, ln_g + (size_t)(l * 3 + 1) * DM, ln_b + (size_t)(l * 3 + 1) * DM, X, XB, (float*)nullptr);
            hipLaunchKernelGGL(k_router, dim3(NTOK / 4), dim3(256), 0, stream, X, wr_group + (size_t)l * DM * 4, br_group + (size_t)l * 4, wr_expert + (size_t)l * 4 * DM * 8, br_expert + (size_t)l * 32, cnt, LIST, GATE);
        }
        bf16* OUT2 = (bf16*)(SCR + 96 * MiB);
        if (FM & 256) { phase(base + 9, base + 10); phase(base + 10, base + 11); }
        else {
            float* HID = (float*)SCR;
            hipLaunchKernelGGL(k_offsets, dim3(1), dim3(64), 0, stream, cnt, off);
            ngemm(PMoe1{XB, LIST, cnt, off, w1 + (size_t)l * NEXP * DM * DEXP, HID, 0, 0}, DEXP, NTOK, NEXP, stream);
            ngemm(PMoe1{XB, LIST, cnt, off, w3 + (size_t)l * NEXP * DM * DEXP, HID, 1, 0}, DEXP, NTOK, NEXP, stream);
            ngemm(PMoe2{HID, LIST, cnt, off, w2 + (size_t)l * NEXP * DEXP * DM, GATE, OUT2}, DM, NTOK, NEXP, stream);
        }
        if (FM & 512) phase(base + 11, base + 12);
        else hipLaunchKernelGGL(k_ln, dim3(NTOK / 4), dim3(256), 0, stream, (const float*)nullptr, X, OUT2, ln_g + (size_t)(l * 3 + 2) * DM, ln_b + (size_t)(l * 3 + 2) * DM, X, XB, (l == DEPTH - 1) ? (float*)d_out : (float*)nullptr);
    }
}
```

```cpp
#include <hip/hip_runtime.h>
#include <cstdio>
#include <cstdint>
#include <cstddef>

typedef unsigned short bf16;
__device__ __forceinline__ unsigned f2bf(float f) { unsigned u = __builtin_bit_cast(unsigned, f); return (u + 0x7fffu + ((u >> 16) & 1u)) >> 16; }
__device__ __forceinline__ float bf2f(bf16 b) { return __builtin_bit_cast(float, ((unsigned)b) << 16); }

constexpr int DM = 1024, BATCH = 4, SEQ = 4096, NTOK = BATCH * SEQ, DEPTH = 4, MEM = 256, NMEM = BATCH * MEM;
constexpr int DPOOL = 512, DSG = 512, NHSG = 4, CHUNK = 128, DIN_E = DPOOL + 2 * DSG, DIN_O = 3 * DM;
constexpr int NXH = 4, XHD = 256, NGRP = 4, EPG = 8, NEXP = 32, DEXP = 512;
constexpr float ALPHA = 1.6817928305074290f;
constexpr float LN_EPS = 1e-5f;
constexpr int LIST_CAP = NTOK;

constexpr size_t MiB = 1u << 20;
constexpr size_t WS_CTL = 0, CTL_BYTES = 1 * MiB;
constexpr size_t WS_X = 1 * MiB;
constexpr size_t WS_XB = WS_X + 64 * MiB;
constexpr size_t WS_Y = WS_XB + 32 * MiB;
constexpr size_t WS_CAT = WS_Y + 64 * MiB;
constexpr size_t WS_KV = WS_CAT + 32 * MiB;
constexpr size_t WS_MEMB = WS_KV + 16 * MiB;
constexpr size_t WS_LIST = WS_MEMB + 2 * MiB;
constexpr size_t WS_GATE = WS_LIST + 2 * MiB;
constexpr size_t WS_SCR = WS_GATE + 1 * MiB;
constexpr size_t WS_END = WS_SCR + 160 * MiB;
constexpr int CW_CNT = 16384, CNT_STRIDE = 64;
constexpr int CW_OFF = 4096;

template <class P>
__global__ __launch_bounds__(256) void k_ngemm(P p) {
    __shared__ float As[16][132];
    __shared__ float Bs[16][132];
    const int z = blockIdx.z, m0 = blockIdx.y * 128, n0 = blockIdx.x * 128;
    const int rows = p.rows(z);
    if (m0 >= rows) return;
    const float* B = p.b(z); const int ldb = p.ldb(); const int K = p.K();
    const int tid = threadIdx.x, tx = tid & 15, ty = tid >> 4;
    float acc[8][8];
#pragma unroll
    for (int i = 0; i < 8; ++i)
#pragma unroll
        for (int j = 0; j < 8; ++j) acc[i][j] = 0.f;
    for (int k0 = 0; k0 < K; k0 += 16) {
#pragma unroll
        for (int i = 0; i < 8; ++i) { const int idx = tid + i * 256, r = idx >> 4, kk = idx & 15; As[kk][r] = (m0 + r < rows) ? p.a(z, m0 + r, k0 + kk) : 0.f; }
#pragma unroll
        for (int i = 0; i < 8; ++i) { const int idx = tid + i * 256, kk = idx >> 7, n = idx & 127; Bs[kk][n] = B[(size_t)(k0 + kk) * ldb + n0 + n]; }
        __syncthreads();
#pragma unroll
        for (int kk = 0; kk < 16; ++kk) {
            float a[8], b[8];
#pragma unroll
            for (int i = 0; i < 8; ++i) a[i] = As[kk][ty + 16 * i];
#pragma unroll
            for (int j = 0; j < 8; ++j) b[j] = Bs[kk][tx + 16 * j];
#pragma unroll
            for (int i = 0; i < 8; ++i)
#pragma unroll
                for (int j = 0; j < 8; ++j) acc[i][j] += a[i] * b[j];
        }
        __syncthreads();
    }
#pragma unroll
    for (int i = 0; i < 8; ++i) { const int m = m0 + ty + 16 * i; if (m < rows) {
#pragma unroll
        for (int j = 0; j < 8; ++j) p.store(z, m, n0 + tx + 16 * j, acc[i][j]); } }
}

struct PBf16ToF32 {
    const bf16* A; const float* B; float* C; int lda, ldb_, K_, M, ldc, pad;
    __device__ int rows(int) const { return M; } __device__ const float* b(int) const { return B; } __device__ int ldb() const { return ldb_; } __device__ int K() const { return K_; }
    __device__ float a(int, int m, int k) const { return bf2f(A[(size_t)m * lda + k]); }
    __device__ void store(int, int m, int n, float v) const { C[(size_t)m * ldc + n] = v; }
};
struct PBf16MulF32 {
    const bf16* A; const float* B; float* C; int lda, ldb_, K_, M, ldc, pad;
    __device__ int rows(int) const { return M; } __device__ const float* b(int) const { return B; } __device__ int ldb() const { return ldb_; } __device__ int K() const { return K_; }
    __device__ float a(int, int m, int k) const { return bf2f(A[(size_t)m * lda + k]); }
    __device__ void store(int, int m, int n, float v) const { C[(size_t)m * ldc + n] *= v; }
};
struct PBf16ToBf16 {
    const bf16* A; const float* B; bf16* C; int lda, ldb_, K_, M, ldc, transpose;
    __device__ int rows(int) const { return M; } __device__ const float* b(int) const { return B; } __device__ int ldb() const { return ldb_; } __device__ int K() const { return K_; }
    __device__ float a(int, int m, int k) const { return bf2f(A[(size_t)m * lda + k]); }
    __device__ void store(int, int m, int n, float v) const { if (transpose) C[(size_t)n * ldc + m] = (bf16)f2bf(v); else C[(size_t)m * ldc + n] = (bf16)f2bf(v); }
};
struct PResid {
    const bf16* A; const float* B; const float* X; float* Y; int lda, ldb_, K_, M;
    __device__ int rows(int) const { return M; } __device__ const float* b(int) const { return B; } __device__ int ldb() const { return ldb_; } __device__ int K() const { return K_; }
    __device__ float a(int, int m, int k) const { return bf2f(A[(size_t)m * lda + k]); }
    __device__ void store(int, int m, int n, float v) const { Y[(size_t)m * DM + n] = ALPHA * X[(size_t)m * DM + n] + v; }
};
struct PPool {
    const float* D; const float* W; const float* scale; bf16* cat;
    __device__ int rows(int) const { return NTOK; } __device__ const float* b(int z) const { return W + (size_t)z * 128 * 128; } __device__ int ldb() const { return 128; } __device__ int K() const { return 128; }
    __device__ float a(int z, int m, int k) const { return D[(size_t)m * 512 + z * 128 + k]; }
    __device__ void store(int z, int m, int n, float v) const { cat[(size_t)m * DM + z * 128 + n] = (bf16)f2bf(v * scale[z * 128 + n]); }
};
struct PMoe1 {
    const bf16* xb; const int* list; const unsigned* cnt; const unsigned* off; const float* W; float* hid; int mode, pad;
    __device__ int rows(int z) const { return (int)cnt[z * CNT_STRIDE]; } __device__ const float* b(int z) const { return W + (size_t)z * DM * DEXP; } __device__ int ldb() const { return DEXP; } __device__ int K() const { return DM; }
    __device__ float a(int z, int m, int k) const { const int slot = list[(size_t)z * LIST_CAP + m]; return bf2f(xb[(size_t)(slot >> 1) * DM + k]); }
    __device__ void store(int z, int m, int n, float v) const { float* h = hid + (size_t)(off[z] + m) * DEXP + n; if (mode == 0) *h = v; else { const float g = *h; *h = g / (1.f + __expf(-g)) * v; } }
};
struct PMoe2 {
    const float* hid; const int* list; const unsigned* cnt; const unsigned* off; const float* W; const float* gate; bf16* out2;
    __device__ int rows(int z) const { return (int)cnt[z * CNT_STRIDE]; } __device__ const float* b(int z) const { return W + (size_t)z * DEXP * DM; } __device__ int ldb() const { return DM; } __device__ int K() const { return DEXP; }
    __device__ float a(int z, int m, int k) const { return hid[(size_t)(off[z] + m) * DEXP + k]; }
    __device__ void store(int z, int m, int n, float v) const { const int slot = list[(size_t)z * LIST_CAP + m]; out2[(size_t)slot * DM + n] = (bf16)f2bf(v * gate[slot]); }
};

__global__ void k_cvt(const float* in, float* outf, bf16* outb, size_t n) {
    for (size_t i = (size_t)blockIdx.x * blockDim.x + threadIdx.x; i < n; i += (size_t)gridDim.x * blockDim.x) { const float v = in[i]; if (outf) outf[i] = v; outb[i] = (bf16)f2bf(v); }
}
__device__ __forceinline__ float wave_sum(float v) {
#pragma unroll
    for (int o = 1; o < 64; o <<= 1) v += __shfl_xor(v, o);
    return v;
}
__device__ __forceinline__ float gelu_tanh(float x) { const float u = 0.7978845608028654f * (x + 0.044715f * x * x * x); return 0.5f * x * (1.f + tanhf(u)); }

__global__ __launch_bounds__(256) void k_ln(const float* Y, const float* resid, const bf16* add2, const float* g, const float* b, float* xf, bf16* xb, float* xf2) {
    const int row = blockIdx.x * 4 + (threadIdx.x >> 6), lane = threadIdx.x & 63;
    float v[16]; float s = 0.f;
#pragma unroll
    for (int j = 0; j < 16; ++j) { const int c = lane + 64 * j; float t;
        if (add2) t = ALPHA * resid[(size_t)row * DM + c] + bf2f(add2[(size_t)(2 * row) * DM + c]) + bf2f(add2[(size_t)(2 * row + 1) * DM + c]);
        else t = Y[(size_t)row * DM + c];
        v[j] = t; s += t; }
    const float mean = wave_sum(s) * (1.f / DM); float q = 0.f;
#pragma unroll
    for (int j = 0; j < 16; ++j) { const float d = v[j] - mean; q += d * d; }
    const float rstd = 1.f / sqrtf(wave_sum(q) * (1.f / DM) + LN_EPS);
#pragma unroll
    for (int j = 0; j < 16; ++j) { const int c = lane + 64 * j; const float o = (v[j] - mean) * rstd * g[c] + b[c]; xf[(size_t)row * DM + c] = o; xb[(size_t)row * DM + c] = (bf16)f2bf(o); if (xf2) xf2[(size_t)row * DM + c] = o; }
}

__global__ void k_even_pool(const float* Hf, float* D) {
    const size_t i = (size_t)blockIdx.x * blockDim.x + threadIdx.x; if (i >= (size_t)NTOK * 512) return;
    const int t = (int)(i / 512), ch = (int)(i % 512), g = ch / 128, w = 2 << g, s = t % SEQ, cnt = (s + 1 < w) ? s + 1 : w;
    float sum = 0.f; for (int j = 0; j < cnt; ++j) sum += Hf[(size_t)(t - j) * DIN_E + ch];
    D[i] = sum / (float)cnt - Hf[(size_t)t * DIN_E + ch];
}
__global__ __launch_bounds__(256) void k_even_gelu_ln(float* Hf, const float* lg, const float* lb) {
    const int row = blockIdx.x * 4 + (threadIdx.x >> 6), lane = threadIdx.x & 63;
    float* h = Hf + (size_t)row * DIN_E;
    for (int j = 0; j < 8; ++j) { const int c = 512 + lane + 64 * j; h[c] = gelu_tanh(h[c]); }
    float v[8]; float s = 0.f;
#pragma unroll
    for (int j = 0; j < 8; ++j) { v[j] = gelu_tanh(h[1024 + lane + 64 * j]); s += v[j]; }
    const float mean = wave_sum(s) * (1.f / 512.f); float q = 0.f;
#pragma unroll
    for (int j = 0; j < 8; ++j) { const float d = v[j] - mean; q += d * d; }
    const float rstd = 1.f / sqrtf(wave_sum(q) * (1.f / 512.f) + LN_EPS);
#pragma unroll
    for (int j = 0; j < 8; ++j) { const int c = lane + 64 * j; h[1024 + c] = (v[j] - mean) * rstd * lg[c] + lb[c]; }
}
__global__ void k_even_gate(const float* Hf, const float* wsp, const float* bsp, bf16* cat) {
    const size_t idx = (size_t)blockIdx.x * blockDim.x + threadIdx.x; if (idx >= (size_t)NTOK * 512) return;
    const int t = (int)(idx / 512), hc = (int)(idx % 512), h = hc / 128, i = t % CHUNK, tb = t - i;
    const float* wrow = wsp + ((size_t)h * CHUNK + i) * CHUNK;
    float sv = 0.f; for (int j = 0; j <= i; ++j) sv += wrow[j] * Hf[(size_t)(tb + j) * DIN_E + 1024 + hc];
    sv += bsp[h * CHUNK + i];
    cat[(size_t)t * DM + 512 + hc] = (bf16)f2bf(Hf[(size_t)t * DIN_E + 512 + hc] * sv);
}
__global__ void k_odd_conv(const float* zc, const float* bg, const float* cw, const float* cb, bf16* cat) {
    const size_t idx = (size_t)blockIdx.x * blockDim.x + threadIdx.x; if (idx >= (size_t)NTOK * DM) return;
    const int t = (int)(idx / DM), c = (int)(idx % DM), s = t % SEQ;
    float conv = cb[c] + zc[idx] * cw[c * 3 + 2];
    if (s >= 1) conv += zc[idx - DM] * cw[c * 3 + 1];
    if (s >= 2) conv += zc[idx - 2 * DM] * cw[c * 3 + 0];
    cat[idx] = (bf16)f2bf(bg[idx] * conv);
}
__global__ __launch_bounds__(256) void k_attn(const bf16* q, const bf16* K, const bf16* V, int ldkv, bf16* o) {
    __shared__ float qs[256]; __shared__ float ps[256]; __shared__ float red[8];
    const int t = blockIdx.x, h = blockIdx.y, b = t / SEQ, tid = threadIdx.x, lane = tid & 63, w = tid >> 6;
    qs[tid] = bf2f(q[(size_t)t * DM + h * XHD + tid]);
    __syncthreads();
    const uint4* kr = (const uint4*)(K + (size_t)(b * MEM + tid) * ldkv + h * XHD);
    float s = 0.f;
    for (int d8 = 0; d8 < XHD / 8; ++d8) { const uint4 kv = kr[d8]; const unsigned w4[4] = {kv.x, kv.y, kv.z, kv.w};
#pragma unroll
        for (int j = 0; j < 4; ++j) { s += qs[d8 * 8 + 2 * j] * __builtin_bit_cast(float, w4[j] << 16); s += qs[d8 * 8 + 2 * j + 1] * __builtin_bit_cast(float, w4[j] & 0xffff0000u); } }
    s *= 0.0625f;
    float m = s;
#pragma unroll
    for (int off = 1; off < 64; off <<= 1) m = fmaxf(m, __shfl_xor(m, off));
    if (lane == 0) red[w] = m;
    __syncthreads();
    m = fmaxf(fmaxf(red[0], red[1]), fmaxf(red[2], red[3]));
    const float e = __expf(s - m);
    float sum = wave_sum(e);
    if (lane == 0) red[4 + w] = sum;
    ps[tid] = e;
    __syncthreads();
    sum = red[4] + red[5] + red[6] + red[7];
    const bf16* vr = V + (size_t)(b * MEM) * ldkv + h * XHD + tid;
    float acc = 0.f;
    for (int j = 0; j < MEM; ++j) acc += ps[j] * bf2f(vr[(size_t)j * ldkv]);
    o[(size_t)t * DM + h * XHD + tid] = (bf16)f2bf(acc / sum);
}
__global__ __launch_bounds__(256) void k_router(const float* x, const float* wrg, const float* brg, const float* wre, const float* bre, unsigned* cnt, int* list, float* gate) {
    const int t = blockIdx.x * 4 + (threadIdx.x >> 6), lane = threadIdx.x & 63;
    float g0 = 0.f, g1 = 0.f, g2 = 0.f, g3 = 0.f;
    for (int k = lane; k < DM; k += 64) { const float xv = x[(size_t)t * DM + k]; const float4 w = *(const float4*)(wrg + k * 4); g0 += xv * w.x; g1 += xv * w.y; g2 += xv * w.z; g3 += xv * w.w; }
    g0 = wave_sum(g0) + brg[0]; g1 = wave_sum(g1) + brg[1]; g2 = wave_sum(g2) + brg[2]; g3 = wave_sum(g3) + brg[3];
    int gs = 0; float gm = g0;
    if (g1 > gm) { gm = g1; gs = 1; }
    if (g2 > gm) { gm = g2; gs = 2; }
    if (g3 > gm) { gm = g3; gs = 3; }
    gs = __builtin_amdgcn_readfirstlane(gs);
    const float gate_g = 1.f / (__expf(g0 - gm) + __expf(g1 - gm) + __expf(g2 - gm) + __expf(g3 - gm));
    float e0 = 0.f, e1 = 0.f, e2 = 0.f, e3 = 0.f, e4 = 0.f, e5 = 0.f, e6 = 0.f, e7 = 0.f;
    const float* we = wre + (size_t)gs * DM * 8;
    for (int k = lane; k < DM; k += 64) { const float xv = x[(size_t)t * DM + k]; const float4 wa = *(const float4*)(we + k * 8), wb = *(const float4*)(we + k * 8 + 4);
        e0 += xv * wa.x; e1 += xv * wa.y; e2 += xv * wa.z; e3 += xv * wa.w; e4 += xv * wb.x; e5 += xv * wb.y; e6 += xv * wb.z; e7 += xv * wb.w; }
    const float* be = bre + gs * 8;
    e0 = wave_sum(e0) + be[0]; e1 = wave_sum(e1) + be[1]; e2 = wave_sum(e2) + be[2]; e3 = wave_sum(e3) + be[3];
    e4 = wave_sum(e4) + be[4]; e5 = wave_sum(e5) + be[5]; e6 = wave_sum(e6) + be[6]; e7 = wave_sum(e7) + be[7];
    int i1 = 0; float v1 = e0;
    if (e1 > v1) { v1 = e1; i1 = 1; } if (e2 > v1) { v1 = e2; i1 = 2; } if (e3 > v1) { v1 = e3; i1 = 3; }
    if (e4 > v1) { v1 = e4; i1 = 4; } if (e5 > v1) { v1 = e5; i1 = 5; } if (e6 > v1) { v1 = e6; i1 = 6; } if (e7 > v1) { v1 = e7; i1 = 7; }
    int i2 = -1; float v2 = -3.0e38f;
    if (i1 != 0 && e0 > v2) { v2 = e0; i2 = 0; } if (i1 != 1 && e1 > v2) { v2 = e1; i2 = 1; } if (i1 != 2 && e2 > v2) { v2 = e2; i2 = 2; } if (i1 != 3 && e3 > v2) { v2 = e3; i2 = 3; }
    if (i1 != 4 && e4 > v2) { v2 = e4; i2 = 4; } if (i1 != 5 && e5 > v2) { v2 = e5; i2 = 5; } if (i1 != 6 && e6 > v2) { v2 = e6; i2 = 6; } if (i1 != 7 && e7 > v2) { v2 = e7; i2 = 7; }
    if (lane == 0) {
        const float ex = __expf(v2 - v1), w1 = 1.f / (1.f + ex), w2 = ex / (1.f + ex);
        const int x1 = gs * 8 + i1, x2 = gs * 8 + i2;
        gate[2 * t] = gate_g * w1; gate[2 * t + 1] = gate_g * w2;
        const unsigned p1 = atomicAdd(cnt + x1 * CNT_STRIDE, 1u); list[(size_t)x1 * LIST_CAP + p1] = 2 * t;
        const unsigned p2 = atomicAdd(cnt + x2 * CNT_STRIDE, 1u); list[(size_t)x2 * LIST_CAP + p2] = 2 * t + 1;
    }
}
__global__ void k_offsets(const unsigned* cnt, unsigned* off) { if (threadIdx.x == 0 && blockIdx.x == 0) { unsigned a = 0; for (int e = 0; e < NEXP; ++e) { off[e] = a; a += (cnt[e * CNT_STRIDE] + 255u) / 256u * 256u; } off[NEXP] = a; } }

namespace pg8 {
#define PG8_LAS __attribute__((address_space(3)))
typedef unsigned short bf16_t;
typedef short bf16x8 __attribute__((ext_vector_type(8)));
typedef float f32x4 __attribute__((ext_vector_type(4)));
typedef float f32x2 __attribute__((ext_vector_type(2)));
typedef unsigned u32x4 __attribute__((ext_vector_type(4)));
typedef unsigned u32x2 __attribute__((ext_vector_type(2)));
constexpr int BM = 256, BK = 64, HALF = 128, HTB = HALF * BK * 2  , STAGE_BYTES = 8 * HTB, NXCD = 8, WGM = 8;

__host__ __device__ __forceinline__ int lds_byte(int r, int c) { const int st = (r >> 4) * 2 + (c >> 5), rr = r & 15, cc = c & 31, ob = rr * 64 + cc * 2; return st * 1024 + (ob ^ (((ob >> 9) & 1) << 5)); }
__host__ __device__ __forceinline__ void stage_rc(int b, int& R, int& C) { const int st = b / 1024, sb = b % 1024, swz = sb ^ (((sb >> 9) & 1) << 5); R = (st >> 1) * 16 + swz / 64; C = (st & 1) * 32 + (swz % 64) / 2; }
__host__ __device__ __forceinline__ int perm32(int rho) { const int n = rho >> 4, i = rho & 15; return 8 * (i >> 2) + 4 * n + (i & 3); }

struct Unit { int pm, pn, e, rows; };
struct Gemm { const bf16_t* A; const bf16_t* Bt; int lda, ldb, K; };

struct DenseOrder {
    static constexpr bool GATHER = false;
    int nM, nN, nwg, G, c, lda, ldb;
    __device__ void init(int M, int N, int G_, int c_, int lda_, int ldb_) { nM = M / BM; nN = N / BM; nwg = nM * nN; G = G_; c = c_; lda = lda_; ldb = ldb_; }
    __device__ bool next(int i, Unit& u) const {
        const long L = (long)i * G + c; if (L >= nwg) return false;
        int wgid = (int)L; { const int q = nwg / NXCD, r = nwg % NXCD, xcd = wgid % NXCD, off = wgid / NXCD; wgid = (xcd < r ? xcd * (q + 1) : r * (q + 1) + (xcd - r) * q) + off; }
        const int nig = WGM * nN, gid = wgid / nig, fm = gid * WGM, gsz = (nM - fm) < WGM ? (nM - fm) : WGM;
        u.pm = fm + ((wgid % nig) % gsz); u.pn = (wgid % nig) / gsz; u.e = 0; u.rows = BM; return true;
    }
    __device__ size_t a_off(const Unit& u) const { return (size_t)u.pm * BM * lda * 2; }
    __device__ size_t b_off(const Unit& u) const { return (size_t)u.pn * BM * ldb * 2; }
    __device__ int a_row(const Unit&, int) const { return 0; }
};

__device__ __forceinline__ unsigned cvt_pk_bf16(float lo, float hi) { unsigned r; asm volatile("v_cvt_pk_bf16_f32 %0, %1, %2" : "=v"(r) : "v"(lo), "v"(hi)); return r; }

template <class Epi, class Sched, bool ALIGN_EPI>
__device__ __forceinline__ void gemm_phase(PG8_LAS unsigned char* lds, const Gemm g, const Sched& S, const Epi& E) {
    int tid_ = threadIdx.x; asm volatile("" : "+v"(tid_));
    const int tid = tid_, wid = __builtin_amdgcn_readfirstlane(tid >> 6), lane = tid & 63, wr = wid >> 2, wc = wid & 3, fr = lane & 15, fq = lane >> 4;
    const int K = g.K, nt = K / BK;
    constexpr int NVA = Sched::GATHER ? 2 : 1;
    unsigned voffA[NVA][2], voffB[2];
#pragma unroll
    for (int i = 0; i < 2; ++i) { int R, C; stage_rc(tid * 16 + i * 8192, R, C); const int Rb = Epi::PERM ? ((R & ~31) + perm32(R & 31)) : R;
        voffA[0][i] = (unsigned)(R * g.lda + C) * 2u; voffB[i] = (unsigned)(Rb * g.ldb + C) * 2u; }
    const size_t kstep = (size_t)(BK * 2);
    const size_t hstepB = (size_t)HALF * g.ldb * 2;
    const size_t hstepA = Sched::GATHER ? (size_t)0 : (size_t)HALF * g.lda * 2;
#define PG8_VA1 voffA[NVA - 1]
#define PG8_GATHER_OFFS(dst, unit) do { int _t = tid; asm volatile("" : "+v"(_t)); _Pragma("unroll") for (int _h = 0; _h < 2; ++_h) _Pragma("unroll") for (int _i = 0; _i < 2; ++_i) { int _R, _C; stage_rc(_t * 16 + _i * 8192, _R, _C); \
        dst[_h][_i] = (unsigned)(S.a_row(unit, _R + _h * HALF) * g.lda + _C) * 2u; } } while (0)
    const unsigned ldsw = (unsigned)wid * 1024u;
    const int aoff = lds_byte(wr * 64 + fr, fq * 8), boff = lds_byte(wc * 32 + fr, fq * 8);
#define PG8_SA(b, h) (((b) * 2 + (h)) * HTB)
#define PG8_SB(b, h) ((4 + (b) * 2 + (h)) * HTB)
#define PG8_STAGE(bufoff, gbase, voff) do { _Pragma("unroll") for (int _i = 0; _i < 2; ++_i) \
        __builtin_amdgcn_global_load_lds((const unsigned*)((const char*)(gbase) + (voff)[_i]), (PG8_LAS unsigned*)(lds + (bufoff) + ldsw + _i * 8192), 16, 0, 0); } while (0)
#define PG8_LDA(dst, b, h) do { _Pragma("unroll") for (int m = 0; m < 4; ++m) _Pragma("unroll") for (int k = 0; k < 2; ++k) dst[m][k] = *(const PG8_LAS bf16x8*)(lds + PG8_SA(b, h) + aoff + m * 2048 + k * 1024); } while (0)
#define PG8_LDB(dst, b, h) do { _Pragma("unroll") for (int n = 0; n < 2; ++n) _Pragma("unroll") for (int k = 0; k < 2; ++k) dst[n][k] = *(const PG8_LAS bf16x8*)(lds + PG8_SB(b, h) + boff + n * 2048 + k * 1024); } while (0)
#define PG8_MMA(ai, bj, At, Bt) do { __builtin_amdgcn_s_setprio(1); _Pragma("unroll") for (int m = 0; m < 4; ++m) _Pragma("unroll") for (int n = 0; n < 2; ++n) _Pragma("unroll") for (int k = 0; k < 2; ++k) \
        acc[ai][bj][m][n] = __builtin_amdgcn_mfma_f32_16x16x32_bf16(Bt[n][k], At[m][k], acc[ai][bj][m][n], 0, 0, 0); __builtin_amdgcn_s_setprio(0); } while (0)
#define PG8_WAIT_V(n) asm volatile("s_waitcnt vmcnt(" #n ")" ::: "memory")
#define PG8_WAIT_L(n) asm volatile("s_waitcnt lgkmcnt(" #n ")" ::: "memory")
#define PG8_BAR __builtin_amdgcn_s_barrier()
#define PG8_SCHED __builtin_amdgcn_sched_barrier(0)
    Unit cur, nxt; int ui = 0;
    if (!S.next(0, cur)) return;
    f32x4 acc[2][2][4][2];
#pragma unroll
    for (int a = 0; a < 2; ++a)
#pragma unroll
        for (int b = 0; b < 2; ++b)
#pragma unroll
            for (int m = 0; m < 4; ++m)
#pragma unroll
                for (int n = 0; n < 2; ++n) acc[a][b][m][n] = (f32x4){0.f, 0.f, 0.f, 0.f};
    bf16x8 At[4][2], B0[2][2], B1[2][2];
    const char* cA = (const char*)g.A + S.a_off(cur); const char* cB = (const char*)g.Bt + S.b_off(cur);
    if constexpr (Sched::GATHER) { PG8_GATHER_OFFS(voffA, cur); }
    PG8_STAGE(PG8_SB(0, 0), cB, voffB); PG8_STAGE(PG8_SB(0, 1), cB + hstepB, voffB); PG8_STAGE(PG8_SA(0, 0), cA, voffA[0]); PG8_STAGE(PG8_SA(0, 1), cA + hstepA, PG8_VA1);
    if (wr == 1) PG8_BAR;
    PG8_WAIT_V(2); PG8_BAR;
    PG8_STAGE(PG8_SB(1, 0), cB + kstep, voffB); PG8_STAGE(PG8_SA(1, 0), cA + kstep, voffA[0]); PG8_STAGE(PG8_SB(1, 1), cB + hstepB + kstep, voffB);
    PG8_WAIT_V(6); PG8_BAR;
    for (;;) {
        const bool has_next = S.next(ui + 1, nxt);
        const char* nA = has_next ? (const char*)g.A + S.a_off(nxt) : cA; const char* nB = has_next ? (const char*)g.Bt + S.b_off(nxt) : cB;
        for (int t = 0; t < nt; t += 2) {
            const bool last = (t == nt - 2);
            const char* a1 = cA + (size_t)(t + 1) * kstep;
            const char* a2 = last ? nA : cA + (size_t)(t + 2) * kstep; const char* b2 = last ? nB : cB + (size_t)(t + 2) * kstep;
            const char* a3 = a2 + kstep; const char* b3 = b2 + kstep;
            unsigned nvo[2][2];
            if constexpr (Sched::GATHER) { if (last && has_next) { PG8_GATHER_OFFS(nvo, nxt); } }
            PG8_LDB(B0, 0, 0); PG8_LDB(B1, 0, 1); PG8_SCHED; PG8_LDA(At, 0, 0); PG8_STAGE(PG8_SA(1, 1), a1 + hstepA, PG8_VA1);
            PG8_WAIT_V(8); PG8_WAIT_L(0); PG8_BAR; PG8_MMA(0, 0, At, B0); PG8_MMA(0, 1, At, B1); PG8_BAR; PG8_SCHED;
            if constexpr (Sched::GATHER) { if (last && has_next) {
#pragma unroll
                for (int h = 0; h < NVA; ++h)
#pragma unroll
                    for (int i = 0; i < 2; ++i) voffA[h][i] = nvo[h][i]; } }
            PG8_LDA(At, 0, 1); PG8_STAGE(PG8_SB(0, 0), b2, voffB); PG8_STAGE(PG8_SB(0, 1), b2 + hstepB, voffB); PG8_STAGE(PG8_SA(0, 0), a2, voffA[0]);
            PG8_WAIT_V(8); PG8_WAIT_L(0); PG8_BAR; PG8_MMA(1, 0, At, B0); PG8_MMA(1, 1, At, B1); PG8_BAR; PG8_SCHED;
            PG8_LDB(B0, 1, 0); PG8_LDB(B1, 1, 1); PG8_SCHED; PG8_LDA(At, 1, 0); PG8_STAGE(PG8_SA(0, 1), a2 + hstepA, PG8_VA1);
            PG8_WAIT_V(8); PG8_WAIT_L(0); PG8_BAR; PG8_MMA(0, 0, At, B0); PG8_MMA(0, 1, At, B1); PG8_BAR; PG8_SCHED;
            PG8_LDA(At, 1, 1); PG8_STAGE(PG8_SB(1, 0), b3, voffB); PG8_STAGE(PG8_SB(1, 1), b3 + hstepB, voffB); PG8_STAGE(PG8_SA(1, 0), a3, voffA[0]);
            PG8_WAIT_V(8); PG8_WAIT_L(0); PG8_BAR; PG8_MMA(1, 0, At, B0); PG8_MMA(1, 1, At, B1); PG8_BAR; PG8_SCHED;
        }
        if constexpr (ALIGN_EPI) { if (wr == 0) PG8_BAR; }
        if constexpr (!Epi::AFTER_DRAIN) { E(acc, cur, wr, wc, fr, fq); }
        if (!has_next) break;
#pragma unroll
        for (int a = 0; a < 2; ++a)
#pragma unroll
            for (int b = 0; b < 2; ++b)
#pragma unroll
                for (int m = 0; m < 4; ++m)
#pragma unroll
                    for (int n = 0; n < 2; ++n) acc[a][b][m][n] = (f32x4){0.f, 0.f, 0.f, 0.f};
        cur = nxt; cA = nA; cB = nB; ++ui;
        if constexpr (ALIGN_EPI) { if (wr == 1) PG8_BAR; }
    }
    PG8_WAIT_V(0);
    if constexpr (!ALIGN_EPI) { if (wr == 0) PG8_BAR; }
    PG8_BAR;
    if constexpr (Epi::AFTER_DRAIN) { E.fused(acc, cur, wr, wc, fr, fq, lds, wid, lane); }
#undef PG8_SA
#undef PG8_VA1
#undef PG8_GATHER_OFFS
#undef PG8_SB
#undef PG8_STAGE
#undef PG8_LDA
#undef PG8_LDB
#undef PG8_MMA
#undef PG8_WAIT_V
#undef PG8_WAIT_L
#undef PG8_BAR
#undef PG8_SCHED
}
}
namespace pg8 {
__device__ __forceinline__ float gelu_tanh_f(float x) {
    const float u = x * (0.7978845608028654f + 0.035677408136300125f * x * x);
    const float e = __builtin_amdgcn_exp2f(-2.8853900817779268f * u);
    return x * __builtin_amdgcn_rcpf(1.0f + e);
}
__device__ __forceinline__ float silu_f(float x) { return x * __builtin_amdgcn_rcpf(1.0f + __builtin_amdgcn_exp2f(-1.4426950408889634f * x)); }

struct EpiResid {
    static constexpr bool PERM = false, AFTER_DRAIN = false;
    const float* X; float* Y; int ldc; float alpha;
    __device__ __forceinline__ void operator()(const f32x4 (&acc)[2][2][4][2], const Unit& u, int wr, int wc, int fr, int fq) const {
        const int row0 = u.pm * BM + wr * 64 + fr, col0 = u.pn * BM + wc * 32 + 4 * fq;
#pragma unroll
        for (int ai = 0; ai < 2; ++ai)
#pragma unroll
            for (int m = 0; m < 4; ++m) { const size_t off = (size_t)(row0 + ai * HALF + m * 16) * ldc + col0;
#pragma unroll
                for (int bj = 0; bj < 2; ++bj)
#pragma unroll
                    for (int n = 0; n < 2; ++n) { const f32x4 xv = *(const f32x4*)(X + off + bj * HALF + n * 16); *(f32x4*)(Y + off + bj * HALF + n * 16) = xv * alpha + acc[ai][bj][m][n]; }
                asm volatile("" ::: "memory"); }
    }
};
struct EpiBf16 {
    static constexpr bool PERM = true, AFTER_DRAIN = false;
    bf16_t* O; int ldc; int gelu_from;
    __device__ __forceinline__ void operator()(const f32x4 (&acc)[2][2][4][2], const Unit& u, int wr, int wc, int fr, int fq) const {
        const int row0 = u.pm * BM + wr * 64 + fr, col0 = u.pn * BM + wc * 32 + 8 * fq;
        const bool act = u.pn >= gelu_from;
#pragma unroll
        for (int ai = 0; ai < 2; ++ai)
#pragma unroll
            for (int m = 0; m < 4; ++m) { bf16_t* rowp = O + (size_t)(row0 + ai * HALF + m * 16) * ldc + col0;
#pragma unroll
                for (int bj = 0; bj < 2; ++bj) { f32x4 v0 = acc[ai][bj][m][0], v1 = acc[ai][bj][m][1];
                    if (act) {
#pragma unroll
                        for (int j = 0; j < 4; ++j) { v0[j] = gelu_tanh_f(v0[j]); v1[j] = gelu_tanh_f(v1[j]); } }
                    u32x4 w; w.x = cvt_pk_bf16(v0[0], v0[1]); w.y = cvt_pk_bf16(v0[2], v0[3]); w.z = cvt_pk_bf16(v1[0], v1[1]); w.w = cvt_pk_bf16(v1[2], v1[3]);
                    *(u32x4*)(rowp + bj * HALF) = w; } }
    }
};
template <int MODE> struct EpiPair {
    static constexpr bool PERM = true, AFTER_DRAIN = false;
    bf16_t* O; bf16_t* O2; int ldc, npair, ldc2;
    __device__ __forceinline__ void operator()(const f32x4 (&acc)[2][2][4][2], const Unit& u, int wr, int wc, int fr, int fq) const {
        const int row0 = u.pm * BM + wr * 64 + fr;
        if (u.pn < npair) {
            const int col0 = u.pn * HALF + wc * 32 + 8 * fq;
#pragma unroll
            for (int ai = 0; ai < 2; ++ai)
#pragma unroll
                for (int m = 0; m < 4; ++m) { bf16_t* rowp = O + (size_t)(row0 + ai * HALF + m * 16) * ldc + col0;
                    f32x4 v0, v1;
#pragma unroll
                    for (int j = 0; j < 4; ++j) { const float a0 = acc[ai][0][m][0][j], a1 = acc[ai][0][m][1][j];
                        v0[j] = (MODE == 1 ? silu_f(a0) : a0) * acc[ai][1][m][0][j]; v1[j] = (MODE == 1 ? silu_f(a1) : a1) * acc[ai][1][m][1][j]; }
                    u32x4 w; w.x = cvt_pk_bf16(v0[0], v0[1]); w.y = cvt_pk_bf16(v0[2], v0[3]); w.z = cvt_pk_bf16(v1[0], v1[1]); w.w = cvt_pk_bf16(v1[2], v1[3]);
                    *(u32x4*)rowp = w; }
        } else {
            const int col0 = (u.pn - npair) * BM + wc * 32 + 8 * fq;
#pragma unroll
            for (int ai = 0; ai < 2; ++ai)
#pragma unroll
                for (int m = 0; m < 4; ++m) { bf16_t* rowp = O2 + (size_t)(row0 + ai * HALF + m * 16) * ldc2 + col0;
#pragma unroll
                    for (int bj = 0; bj < 2; ++bj) { const f32x4 v0 = acc[ai][bj][m][0], v1 = acc[ai][bj][m][1];
                        u32x4 w; w.x = cvt_pk_bf16(v0[0], v0[1]); w.y = cvt_pk_bf16(v0[2], v0[3]); w.z = cvt_pk_bf16(v1[0], v1[1]); w.w = cvt_pk_bf16(v1[2], v1[3]);
                        *(u32x4*)(rowp + bj * HALF) = w; } }
        }
    }
};
struct EpiMoe1 {
    static constexpr bool PERM = true, AFTER_DRAIN = false;
    bf16_t* HID; const PG8_LAS int* tab;
    __device__ __forceinline__ void operator()(const f32x4 (&acc)[2][2][4][2], const Unit& u, int wr, int wc, int fr, int fq) const {
        const int row0 = (tab[u.e] + u.pm) * BM + wr * 64 + fr, col0 = u.pn * HALF + wc * 32 + 8 * fq;
#pragma unroll
        for (int ai = 0; ai < 2; ++ai)
#pragma unroll
            for (int m = 0; m < 4; ++m) { bf16_t* rowp = HID + (size_t)(row0 + ai * HALF + m * 16) * 512 + col0;
                f32x4 v0, v1;
#pragma unroll
                for (int j = 0; j < 4; ++j) { v0[j] = silu_f(acc[ai][0][m][0][j]) * acc[ai][1][m][0][j]; v1[j] = silu_f(acc[ai][0][m][1][j]) * acc[ai][1][m][1][j]; }
                u32x4 w; w.x = cvt_pk_bf16(v0[0], v0[1]); w.y = cvt_pk_bf16(v0[2], v0[3]); w.z = cvt_pk_bf16(v1[0], v1[1]); w.w = cvt_pk_bf16(v1[2], v1[3]);
                *(u32x4*)rowp = w; }
    }
};
struct EpiMoe2 {
    static constexpr bool PERM = true, AFTER_DRAIN = false;
    bf16_t* OUT2; const int* list; const float* gate; int cap;
    __device__ __forceinline__ void operator()(const f32x4 (&acc)[2][2][4][2], const Unit& u, int wr, int wc, int fr, int fq) const {
        const int r0 = wr * 64 + fr, col0 = u.pn * BM + wc * 32 + 8 * fq;
        const int* lp = list + (size_t)u.e * cap + u.pm * BM;
#pragma unroll
        for (int ai = 0; ai < 2; ++ai)
#pragma unroll
            for (int m = 0; m < 4; ++m) { const int r = r0 + ai * HALF + m * 16;
                if (r < u.rows) { const int slot = lp[r]; const float gt = gate[slot]; bf16_t* rowp = OUT2 + (size_t)slot * 1024 + col0;
#pragma unroll
                    for (int bj = 0; bj < 2; ++bj) { const f32x4 v0 = acc[ai][bj][m][0] * gt, v1 = acc[ai][bj][m][1] * gt;
                        u32x4 w; w.x = cvt_pk_bf16(v0[0], v0[1]); w.y = cvt_pk_bf16(v0[2], v0[3]); w.z = cvt_pk_bf16(v1[0], v1[1]); w.w = cvt_pk_bf16(v1[2], v1[3]);
                        *(u32x4*)(rowp + bj * HALF) = w; } } }
    }
};
struct EpiSoftmax {
    static constexpr bool PERM = true, AFTER_DRAIN = true;
    bf16_t* P; int ldc; float scale_log2e;
    __device__ __forceinline__ void fused(f32x4 (&acc)[2][2][4][2], const Unit& u, int wr, int wc, int fr, int fq, PG8_LAS unsigned char* lds, int wid, int lane) const {
        PG8_LAS float* PM = (PG8_LAS float*)lds;
        PG8_LAS float* PS = (PG8_LAS float*)(lds + 4096);
#pragma unroll
        for (int ai = 0; ai < 2; ++ai)
#pragma unroll
            for (int m = 0; m < 4; ++m) { float mx = -3.0e38f;
#pragma unroll
                for (int bj = 0; bj < 2; ++bj)
#pragma unroll
                    for (int n = 0; n < 2; ++n) { const f32x4 x = acc[ai][bj][m][n]; mx = fmaxf(mx, fmaxf(fmaxf(x[0], x[1]), fmaxf(x[2], x[3]))); }
                mx = fmaxf(mx, __shfl_xor(mx, 16)); mx = fmaxf(mx, __shfl_xor(mx, 32));
                if (fq == 0) PM[(ai * HALF + wr * 64 + m * 16 + fr) * 4 + wc] = mx; }
        asm volatile("s_waitcnt lgkmcnt(0)" ::: "memory"); __builtin_amdgcn_s_barrier(); asm volatile("" ::: "memory");
#pragma unroll
        for (int ai = 0; ai < 2; ++ai)
#pragma unroll
            for (int m = 0; m < 4; ++m) { const int r = ai * HALF + wr * 64 + m * 16 + fr; const f32x4 pm = *(const PG8_LAS f32x4*)(PM + r * 4);
                const float mx = fmaxf(fmaxf(pm[0], pm[1]), fmaxf(pm[2], pm[3])) * scale_log2e; float s = 0.f;
#pragma unroll
                for (int bj = 0; bj < 2; ++bj)
#pragma unroll
                    for (int n = 0; n < 2; ++n) { f32x4 x = acc[ai][bj][m][n];
#pragma unroll
                        for (int j = 0; j < 4; ++j) { x[j] = __builtin_amdgcn_exp2f(x[j] * scale_log2e - mx); s += x[j]; }
                        acc[ai][bj][m][n] = x; }
                s += __shfl_xor(s, 16); s += __shfl_xor(s, 32);
                if (fq == 0) PS[r * 4 + wc] = s; }
        asm volatile("s_waitcnt lgkmcnt(0)" ::: "memory"); __builtin_amdgcn_s_barrier(); asm volatile("" ::: "memory");
        const int row0 = u.pm * BM + wr * 64 + fr, col0 = u.pn * BM + wc * 32 + 8 * fq;
#pragma unroll
        for (int ai = 0; ai < 2; ++ai)
#pragma unroll
            for (int m = 0; m < 4; ++m) { const int r = ai * HALF + wr * 64 + m * 16 + fr; const f32x4 ps = *(const PG8_LAS f32x4*)(PS + r * 4);
                const float inv = 1.0f / ((ps[0] + ps[1]) + (ps[2] + ps[3])); bf16_t* rowp = P + (size_t)(row0 + ai * HALF + m * 16) * ldc + col0;
#pragma unroll
                for (int bj = 0; bj < 2; ++bj) { const f32x4 v0 = acc[ai][bj][m][0] * inv, v1 = acc[ai][bj][m][1] * inv;
                    u32x4 w; w.x = cvt_pk_bf16(v0[0], v0[1]); w.y = cvt_pk_bf16(v0[2], v0[3]); w.z = cvt_pk_bf16(v1[0], v1[1]); w.w = cvt_pk_bf16(v1[2], v1[3]);
                    *(u32x4*)(rowp + bj * HALF) = w; } }
    }
};
}
constexpr int NWAVES = 8;
constexpr int NPL = 10;
constexpr int NPRE = 3;
constexpr int NPHASE = NPRE + DEPTH * NPL;
constexpr size_t WS_W_EIN = WS_END;
constexpr size_t WS_W_EOUT = WS_W_EIN + 6 * MiB;
constexpr size_t WS_W_OIN = WS_W_EOUT + 4 * MiB;
constexpr size_t WS_W_OOUT = WS_W_OIN + 12 * MiB;
constexpr size_t WS_WSB = WS_W_OOUT + 4 * MiB;
constexpr size_t WS_WQ = WS_WSB + 1 * MiB;
constexpr size_t WS_WO = WS_WQ + 8 * MiB;
constexpr size_t WS_WK = WS_WO + 8 * MiB;
constexpr size_t WS_WV = WS_WK + 8 * MiB;
constexpr size_t WS_W13 = WS_WV + 8 * MiB;
constexpr size_t WS_W2 = WS_W13 + 256 * MiB;
constexpr size_t WS_MT = WS_W2 + 128 * MiB;
constexpr size_t WS_VW = WS_MT + 32 * MiB;
constexpr size_t WS_END2 = WS_VW + 32 * MiB;
constexpr int CW_BAR = 8192;
constexpr int RING_BYTES = 131072, LDSCTL_OFF = RING_BYTES, MISC_OFF = LDSCTL_OFF + 320, TAB_OFF = LDSCTL_OFF + 1024;
constexpr int LDS_BYTES = 147456;

#define GAS __attribute__((address_space(1)))
#define LAS __attribute__((address_space(3)))
typedef unsigned v4u __attribute__((ext_vector_type(4)));
typedef unsigned v2u __attribute__((ext_vector_type(2)));
typedef float f32x4 __attribute__((ext_vector_type(4)));
typedef short bf16x8v __attribute__((ext_vector_type(8)));
#define LDS_WAIT() asm volatile("s_waitcnt lgkmcnt(0)" ::: "memory")
#define VM_WAIT() asm volatile("s_waitcnt vmcnt(0)" ::: "memory")
__device__ __forceinline__ unsigned pk2(float lo, float hi) { return f2bf(lo) | (f2bf(hi) << 16); }
__device__ __forceinline__ float bflo(unsigned w) { return __builtin_bit_cast(float, w << 16); }
__device__ __forceinline__ float bfhi(unsigned w) { return __builtin_bit_cast(float, w & 0xffff0000u); }

#define XB_TMO      128
#define XB_XCNT(j)  (256  + 64 * (j))
#define XB_XSUB(j)  (1280 + 64 * (j))
#define XB_XGEN(j)  (2304 + 64 * (j))
#define XB_TOP      3328
#define XB_TOPGEN   3392
#define XCD_BAR_WORDS 3456
#define XB_SPIN_CAP (1u << 18)

__device__ __forceinline__ unsigned xb_ld(unsigned* p)              { return __hip_atomic_load(p, __ATOMIC_RELAXED, __HIP_MEMORY_SCOPE_AGENT); }
__device__ __forceinline__ unsigned xb_add(unsigned* p, unsigned v) { return __hip_atomic_fetch_add(p, v, __ATOMIC_RELAXED, __HIP_MEMORY_SCOPE_AGENT); }
__device__ __forceinline__ unsigned xb_xcc_id() { return (unsigned)__builtin_amdgcn_s_getreg((3 << 11) | 20) & 0xFu; }
#define XB_SPIN(cond, bar) do { unsigned _sp = 0; while (cond) { __builtin_amdgcn_s_sleep(1); \
    if ((++_sp & 255u) == 0u) { if (xb_ld(&(bar)[XB_TMO])) break; if (_sp > XB_SPIN_CAP) { atomicAdd(&(bar)[XB_TMO], 1u); break; } } } } while (0)

struct XcdBarrier {
    unsigned* bar; unsigned x;
    volatile LAS unsigned* st;
};

__device__ __forceinline__ XcdBarrier xcd_barrier_post(unsigned* bar, volatile LAS unsigned* st) {
    XcdBarrier b; b.bar = bar; b.x = xb_xcc_id(); b.st = st;
    if (threadIdx.x == 0) (void)xb_add(&bar[XB_XCNT(b.x)], 1u);
    return b;
}
__device__ __forceinline__ void xcd_barrier_complete(unsigned* bar, unsigned x, unsigned& nloc, unsigned& nx) {
    const unsigned G = gridDim.x * gridDim.y * gridDim.z;
    unsigned sum, cnt, mine, sp = 0u;
    for (;;) {
        sum = 0u; cnt = 0u; mine = 0u;
#pragma unroll
        for (unsigned j = 0; j < 16; ++j) { const unsigned c = xb_ld(&bar[XB_XCNT(j)]); sum += c; cnt += (c > 0u) ? 1u : 0u; mine = (j == x) ? c : mine; }
        if (sum == G) break;
        __builtin_amdgcn_s_sleep(1);
        if ((++sp & 255u) == 0u) { if (xb_ld(&bar[XB_TMO])) break; if (sp > XB_SPIN_CAP) { atomicAdd(&bar[XB_TMO], 1u); break; } }
    }
    nloc = mine > 0u ? mine : 1u; nx = cnt > 0u ? cnt : 1u;
}

__device__ __forceinline__ void xcd_barrier(const XcdBarrier& b) {
    asm volatile("s_waitcnt vmcnt(0)" ::: "memory");
    __syncthreads();
    if (threadIdx.x == 0) {
        unsigned* bar = b.bar;
        __builtin_amdgcn_s_waitcnt(0);
        unsigned nloc = b.st[0], nx = b.st[1];
        if (nloc == 0u) { xcd_barrier_complete(bar, b.x, nloc, nx); b.st[0] = nloc; b.st[1] = nx; }
        const unsigned old = xb_add(&bar[XB_XSUB(b.x)], 1u);
        const unsigned gen = old / nloc;
        if (old + 1u == (gen + 1u) * nloc) {
            __builtin_amdgcn_fence(__ATOMIC_RELEASE, "agent");
            asm volatile("s_waitcnt vmcnt(0)" ::: "memory");
            const unsigned og = xb_add(&bar[XB_TOP], 1u);
            const unsigned tg = og / nx;
            if (og + 1u == (tg + 1u) * nx) xb_add(&bar[XB_TOPGEN], 1u);
            else XB_SPIN(xb_ld(&bar[XB_TOPGEN]) == tg, bar);
            __builtin_amdgcn_fence(__ATOMIC_ACQUIRE, "agent");
            xb_add(&bar[XB_XGEN(b.x)], 1u);
            asm volatile("s_waitcnt vmcnt(0)" ::: "memory");
        } else {
            XB_SPIN(xb_ld(&bar[XB_XGEN(b.x)]) == gen, bar);
            __builtin_amdgcn_fence(__ATOMIC_ACQUIRE, "agent");
            asm volatile("s_waitcnt vmcnt(0)" ::: "memory");
        }
    }
    __syncthreads();
}


struct Args { const float* in[27]; float* out; unsigned char* ws; int ph_lo, ph_hi; };

struct Frame {
    LAS unsigned char* lds;
    int tid, lane, wave, vcu, G;
    unsigned char* ws;
};
__device__ __forceinline__ void frame_refresh(Frame& F) { int t = threadIdx.x; asm volatile("" : "+v"(t)); F.tid = t; F.lane = t & 63; F.wave = __builtin_amdgcn_readfirstlane(t >> 6); }

struct AttnOrder {
    static constexpr bool GATHER = false;
    int G, c, l;
    __device__ bool next(int i, pg8::Unit& u) const {
        const int L = i * G + c; if (L >= 256) return false;
        const int xcd = L & 7, j = L >> 3, b = xcd >> 1, idx = (xcd & 1) * 32 + j;
        u.pm = b * 16 + (idx >> 2); u.pn = idx & 3; u.e = b; u.rows = 256; return true;
    }
    __device__ size_t a_off(const pg8::Unit& u) const { return (size_t)u.pm * 256 * DM * 2; }
    __device__ size_t b_off(const pg8::Unit& u) const { return ((size_t)((l * BATCH + u.e) * DM + u.pn * 256) * DM) * 2; }
    __device__ int a_row(const pg8::Unit&, int) const { return 0; }
};
struct FoldOrder {
    static constexpr bool GATHER = false;
    int G, c, mode;
    __device__ bool next(int i, pg8::Unit& u) const { const int L = i * G + c; if (L >= 256) return false; u.pm = L >> 2; u.pn = L & 3; u.e = 0; u.rows = 256; return true; }
    __device__ size_t a_off(const pg8::Unit& u) const { const int l = u.pm >> 4, b = (u.pm >> 2) & 3, q = u.pm & 3;
        return mode == 0 ? ((size_t)(b * MEM) * (2 * DEPTH * DM) + (size_t)l * DM + (size_t)q * XHD) * 2 : ((size_t)l * DM * DM + (size_t)(q * 256) * DM + (size_t)u.pn * XHD) * 2; }
    __device__ size_t b_off(const pg8::Unit& u) const { const int l = u.pm >> 4, b = (u.pm >> 2) & 3, q = u.pm & 3;
        return mode == 0 ? ((size_t)l * DM * DM + (size_t)(u.pn * 256) * DM + (size_t)q * XHD) * 2 : ((size_t)(b * MEM) * (2 * DEPTH * DM) + (size_t)(DEPTH * DM) + (size_t)l * DM + (size_t)u.pn * XHD) * 2; }
    __device__ int a_row(const pg8::Unit&, int) const { return 0; }
};
template <bool GATHER_> struct MoeOrder {
    static constexpr bool GATHER = GATHER_;
    int G, c, NT; const LAS int* tab; const LAS int* cnt; const int* list; size_t bstride_e; int ldb;
    __device__ bool next(int i, pg8::Unit& u) const {
        const int L = i * G + c; const int total = __builtin_amdgcn_readfirstlane(tab[NEXP]) * NT; if (L >= total) return false;
        const int T = L / NT; int e = 0;
        for (int k = 1; k < NEXP; ++k) { if (__builtin_amdgcn_readfirstlane(tab[k]) <= T) e = k; }
        u.e = e; u.pm = T - __builtin_amdgcn_readfirstlane(tab[e]); u.pn = L - T * NT;
        const int left = __builtin_amdgcn_readfirstlane(cnt[e]) - u.pm * 256; u.rows = left < 256 ? left : 256; return true;
    }
    __device__ size_t a_off(const pg8::Unit& u) const { return GATHER ? (size_t)0 : (size_t)(tab[u.e] + u.pm) * 256 * DEXP * 2; }
    __device__ size_t b_off(const pg8::Unit& u) const { return (size_t)u.e * bstride_e + (size_t)u.pn * 256 * ldb * 2; }
    __device__ int a_row(const pg8::Unit& u, int r) const { const int rr = r < u.rows ? r : u.rows - 1; return list[(size_t)u.e * LIST_CAP + u.pm * 256 + rr] >> 1; }
};
__device__ __forceinline__ void moe_tables(Frame& F, const unsigned* cntg) {
    frame_refresh(F);
    LAS int* tab = (LAS int*)(F.lds + TAB_OFF); LAS int* cl = tab + 40;
    if (F.tid < 64) { const int c = F.tid < NEXP ? (int)cntg[F.tid * CNT_STRIDE] : 0; int tl = (c + 255) >> 8; int inc = tl;
#pragma unroll
        for (int o = 1; o < 32; o <<= 1) { const int t = __shfl_up(inc, o); if (F.lane >= o) inc += t; }
        if (F.tid < NEXP) { tab[F.tid] = inc - tl; cl[F.tid] = c; } if (F.tid == NEXP - 1) tab[NEXP] = inc; }
    LDS_WAIT(); __syncthreads();
}

__device__ __forceinline__ void tr_store(LAS float* scr, bf16* dst, int ldd, int drow0, int k0, int lane) {
    LDS_WAIT(); asm volatile("" ::: "memory");
    const int c = lane & 7;
#pragma unroll
    for (int j = 0; j < 4; ++j) { const int n = (lane >> 3) + 8 * j; const LAS float* s = scr + (8 * c) * 33 + n;
        v4u o; o.x = pk2(s[0 * 33], s[1 * 33]); o.y = pk2(s[2 * 33], s[3 * 33]); o.z = pk2(s[4 * 33], s[5 * 33]); o.w = pk2(s[6 * 33], s[7 * 33]);
        *(GAS v4u*)(dst + (size_t)(drow0 + n) * ldd + k0 + 8 * c) = o; }
    LDS_WAIT(); asm volatile("" ::: "memory");
}
struct TrDesc { const float* src; bf16* dst; int lds_, ldd; };
__device__ __forceinline__ void tr_load(const TrDesc& d, float (&v)[32], int lane) {
#pragma unroll
    for (int i = 0; i < 32; ++i) { const int kk = 2 * i + (lane >> 5); v[i] = __builtin_nontemporal_load(d.src + (size_t)kk * d.lds_ + (lane & 31)); }
}
__device__ __forceinline__ void tr_finish(const TrDesc& d, const float (&v)[32], LAS float* scr, int lane) {
#pragma unroll
    for (int i = 0; i < 32; ++i) { const int kk = 2 * i + (lane >> 5); scr[kk * 33 + (lane & 31)] = v[i]; }
    tr_store(scr, d.dst, d.ldd, 0, 0, lane);
}
__device__ __forceinline__ void fold_item(const float* w_in, const float* w_pool, const float* scale, int k0, int n0, bf16* dst, LAS float* scr, int lane) {
    const int g = n0 >> 7, nn = (n0 & 127) + (lane & 31), kh = lane >> 5;
    float acc[32];
#pragma unroll
    for (int j = 0; j < 32; ++j) acc[j] = 0.f;
    const float* wp = w_pool + (size_t)g * 128 * 128 + nn;
    const float* wi = w_in + (size_t)(k0 + kh) * DIN_E + g * 128;
    for (int c = 0; c < 128; ++c) { const float p = wp[(size_t)c * 128];
#pragma unroll
        for (int j = 0; j < 32; ++j) acc[j] += wi[(size_t)(2 * j) * DIN_E + c] * p; }
    const float sc = scale[n0 + (lane & 31)];
#pragma unroll
    for (int j = 0; j < 32; ++j) scr[(2 * j + kh) * 33 + (lane & 31)] = acc[j] * sc;
    tr_store(scr, dst, DM, n0, k0, lane);
}
__device__ __forceinline__ void cvt_rows(const float* src, bf16* dst, size_t n8, size_t gtid, size_t nthr) {
    for (size_t i = gtid; i < n8; i += nthr) { const f32x4 a = *(const GAS f32x4*)(src + i * 8), b = *(const GAS f32x4*)(src + i * 8 + 4);
        v4u o; o.x = pk2(a.x, a.y); o.y = pk2(a.z, a.w); o.z = pk2(b.x, b.y); o.w = pk2(b.z, b.w); *(GAS v4u*)(dst + i * 8) = o; }
}
__device__ __forceinline__ void prep_phase(Frame& F, const Args& A) {
    frame_refresh(F);
    LAS float* scr = (LAS float*)(F.lds + F.wave * 16384);
    const int gw = F.vcu * NWAVES + F.wave, NGW = F.G * NWAVES, lane = F.lane;
    bf16* W13 = (bf16*)(F.ws + WS_W13); bf16* W2T = (bf16*)(F.ws + WS_W2);
    constexpr int I_W1 = DEPTH * NEXP * 256, I_W2 = DEPTH * NEXP * 256, I_SQ = 16 * 512, I_EIN = 2 * 16 * 32, I_OIN = 2 * 16 * 96, I_FOLD = 2 * 256;
    constexpr int N_TR = 2 * I_W1 + I_W2 + I_SQ + I_EIN + I_OIN;
    auto decode = [&](int r) -> TrDesc {
        if (r < 2 * I_W1) { const int which = r >= I_W1; r -= which * I_W1; const int mat = r >> 8, rem = r & 255, kb = rem >> 4, nb = rem & 15, n0 = nb * 32, drow = (n0 >> 7) * 256 + which * 128 + (n0 & 127);
            return TrDesc{(which ? A.in[25] : A.in[24]) + (size_t)mat * DM * DEXP + (size_t)(kb * 64) * DEXP + n0, W13 + (size_t)mat * DM * DM + (size_t)drow * DM + kb * 64, DEXP, DM}; }
        r -= 2 * I_W1;
        if (r < I_W2) { const int mat = r >> 8, rem = r & 255, kb = rem >> 5, nb = rem & 31;
            return TrDesc{A.in[26] + (size_t)mat * DEXP * DM + (size_t)(kb * 64) * DM + nb * 32, W2T + (size_t)mat * DM * DEXP + (size_t)(nb * 32) * DEXP + kb * 64, DM, DEXP}; }
        r -= I_W2;
        if (r < I_SQ) { const int mat = r >> 9, rem = r & 511, kb = rem >> 5, nb = rem & 31; const float* src; bf16* dst;
            if (mat < 2) { src = A.in[9] + (size_t)mat * DM * DM; dst = (bf16*)(F.ws + WS_W_EOUT) + (size_t)mat * DM * DM; }
            else if (mat < 4) { src = A.in[13] + (size_t)(mat - 2) * DM * DM; dst = (bf16*)(F.ws + WS_W_OOUT) + (size_t)(mat - 2) * DM * DM; }
            else if (mat < 8) { src = A.in[17] + (size_t)(mat - 4) * DM * DM; dst = (bf16*)(F.ws + WS_WO) + (size_t)(mat - 4) * DM * DM; }
            else if (mat < 12) { src = A.in[15] + (size_t)(mat - 8) * DM * DM; dst = (bf16*)(F.ws + WS_WK) + (size_t)(mat - 8) * DM * DM; }
            else { src = A.in[16] + (size_t)(mat - 12) * DM * DM; dst = (bf16*)(F.ws + WS_WV) + (size_t)(mat - 12) * DM * DM; }
            return TrDesc{src + (size_t)(kb * 64) * DM + nb * 32, dst + (size_t)(nb * 32) * DM + kb * 64, DM, DM}; }
        r -= I_SQ;
        if (r < I_EIN) { const int i = r >> 9, rem = r & 511, kb = rem >> 5, nb = rem & 31, n0 = 512 + nb * 32;
            return TrDesc{A.in[2] + (size_t)i * DM * DIN_E + (size_t)(kb * 64) * DIN_E + n0, (bf16*)(F.ws + WS_W_EIN) + (size_t)i * DIN_E * DM + (size_t)n0 * DM + kb * 64, DIN_E, DM}; }
        r -= I_EIN;
        { const int i = r / 1536, rem = r % 1536, kb = rem / 96, nb = rem % 96, n0 = nb * 32; int drow;
            if (n0 < DM) drow = 2048 + n0; else if (n0 < 2 * DM) { const int ch = n0 - DM; drow = (ch >> 7) * 256 + (ch & 127); } else { const int ch = n0 - 2 * DM; drow = (ch >> 7) * 256 + 128 + (ch & 127); }
            return TrDesc{A.in[10] + (size_t)i * DM * DIN_O + (size_t)(kb * 64) * DIN_O + n0, (bf16*)(F.ws + WS_W_OIN) + (size_t)i * DIN_O * DM + (size_t)drow * DM + kb * 64, DIN_O, DM}; }
    };
    {
        float v[32], vn[32]; int it = gw; TrDesc cur{nullptr, nullptr, 0, 0};
        if (it < N_TR) { cur = decode(it); tr_load(cur, v, lane); }
        while (it < N_TR) {
            const int nx = it + NGW; TrDesc nd{nullptr, nullptr, 0, 0};
            if (nx < N_TR) { nd = decode(nx); tr_load(nd, vn, lane); }
            tr_finish(cur, v, scr, lane);
#pragma unroll
            for (int i = 0; i < 32; ++i) v[i] = vn[i];
            cur = nd; it = nx;
        }
    }
    for (int r = gw; r < I_FOLD; r += NGW) { const int i = r >> 8, rem = r & 255, kb = rem >> 4, nb = rem & 15;
        fold_item(A.in[2] + (size_t)i * DM * DIN_E, A.in[3] + (size_t)i * 4 * 128 * 128, A.in[4] + (size_t)i * 512, kb * 64, nb * 32, (bf16*)(F.ws + WS_W_EIN) + (size_t)i * DIN_E * DM, scr, lane); }
    const size_t gtid = (size_t)F.vcu * (NWAVES * 64) + F.tid, nthr = (size_t)F.G * NWAVES * 64;
    cvt_rows(A.in[0], (bf16*)(F.ws + WS_XB), (size_t)NTOK * DM / 8, gtid, nthr);
    cvt_rows(A.in[1], (bf16*)(F.ws + WS_MEMB), (size_t)NMEM * DM / 8, gtid, nthr);
    cvt_rows(A.in[14], (bf16*)(F.ws + WS_WQ), (size_t)DEPTH * DM * DM / 8, gtid, nthr);
    bf16* wsb = (bf16*)(F.ws + WS_WSB);
    for (size_t i = gtid; i < (size_t)2 * 4 * 128 * 128; i += nthr) { const int jj = (int)(i & 127), ii = (int)((i >> 7) & 127); wsb[i] = (jj <= ii) ? (bf16)f2bf(A.in[7][i]) : (bf16)0; }
}

__device__ __forceinline__ float wsum(float v) {
#pragma unroll
    for (int o = 1; o < 64; o <<= 1) v += __shfl_xor(v, o);
    return v;
}
template <int MODE, bool ROUTER, int RB>
__device__ __forceinline__ void ln_phase(Frame& F, const float* Y, const bf16* OUT2, const float* gam, const float* bet, float* X, bf16* XB, float* OUT,
                                         const float* wrg, const float* brg, const float* wre, const float* bre, unsigned* cnt, int* list, float* gate) {
    frame_refresh(F);
    const int gw = F.vcu * NWAVES + F.wave, NGW = F.G * NWAVES, lane = F.lane;
    f32x4 gv[4], bv[4];
#pragma unroll
    for (int j = 0; j < 4; ++j) { gv[j] = *(const GAS f32x4*)(gam + 4 * lane + 256 * j); bv[j] = *(const GAS f32x4*)(bet + 4 * lane + 256 * j); }
    int myE = 0, mySlot = 0, k = 0;
    for (int row0 = gw; row0 < NTOK; row0 += NGW * RB) {
        f32x4 v[RB][4];
        if (MODE == 0) {
#pragma unroll
            for (int r = 0; r < RB; ++r) { const int row = row0 + r * NGW; if (row < NTOK) {
#pragma unroll
                for (int j = 0; j < 4; ++j) v[r][j] = *(const GAS f32x4*)(Y + (size_t)row * DM + 4 * lane + 256 * j); } }
        } else {
            v2u oa[RB][4], ob[RB][4];
#pragma unroll
            for (int r = 0; r < RB; ++r) { const int row = row0 + r * NGW; if (row < NTOK) {
#pragma unroll
                for (int j = 0; j < 4; ++j) { v[r][j] = *(const GAS f32x4*)(X + (size_t)row * DM + 4 * lane + 256 * j);
                    oa[r][j] = *(const GAS v2u*)(OUT2 + (size_t)(2 * row) * DM + 4 * lane + 256 * j); ob[r][j] = *(const GAS v2u*)(OUT2 + (size_t)(2 * row + 1) * DM + 4 * lane + 256 * j); } } }
#pragma unroll
            for (int r = 0; r < RB; ++r)
#pragma unroll
                for (int j = 0; j < 4; ++j) { const f32x4 xv = v[r][j]; const v2u a = oa[r][j], b = ob[r][j];
                    v[r][j].x = ALPHA * xv.x + bflo(a.x) + bflo(b.x); v[r][j].y = ALPHA * xv.y + bfhi(a.x) + bfhi(b.x); v[r][j].z = ALPHA * xv.z + bflo(a.y) + bflo(b.y); v[r][j].w = ALPHA * xv.w + bfhi(a.y) + bfhi(b.y); }
        }
        float s[RB], s2[RB];
#pragma unroll
        for (int r = 0; r < RB; ++r) { s[r] = 0.f;
#pragma unroll
            for (int j = 0; j < 4; ++j) s[r] += (v[r][j].x + v[r][j].y) + (v[r][j].z + v[r][j].w); }
#pragma unroll
        for (int o = 1; o < 64; o <<= 1) {
#pragma unroll
            for (int r = 0; r < RB; ++r) s[r] += __shfl_xor(s[r], o); }
#pragma unroll
        for (int r = 0; r < RB; ++r) { const float mean = s[r] * (1.f / DM); s2[r] = 0.f;
#pragma unroll
            for (int j = 0; j < 4; ++j) { v[r][j] = v[r][j] - mean; s2[r] += (v[r][j].x * v[r][j].x + v[r][j].y * v[r][j].y) + (v[r][j].z * v[r][j].z + v[r][j].w * v[r][j].w); } }
#pragma unroll
        for (int o = 1; o < 64; o <<= 1) {
#pragma unroll
            for (int r = 0; r < RB; ++r) s2[r] += __shfl_xor(s2[r], o); }
#pragma unroll
        for (int r = 0; r < RB; ++r) { const int row = row0 + r * NGW; const float rstd = 1.f / sqrtf(s2[r] * (1.f / DM) + LN_EPS);
            if (row < NTOK) {
#pragma unroll
                for (int j = 0; j < 4; ++j) { v[r][j] = v[r][j] * rstd * gv[j] + bv[j];
                    *(GAS f32x4*)(X + (size_t)row * DM + 4 * lane + 256 * j) = v[r][j];
                    if (OUT) *(GAS f32x4*)(OUT + (size_t)row * DM + 4 * lane + 256 * j) = v[r][j];
                    v2u w; w.x = pk2(v[r][j].x, v[r][j].y); w.y = pk2(v[r][j].z, v[r][j].w); *(GAS v2u*)(XB + (size_t)row * DM + 4 * lane + 256 * j) = w; } } }
        if constexpr (ROUTER) {
            LAS float* xs = (LAS float*)(F.lds + F.wave * (RB * 4096));
#pragma unroll
            for (int r = 0; r < RB; ++r)
#pragma unroll
                for (int j = 0; j < 4; ++j) *(LAS f32x4*)(xs + r * 1024 + 4 * lane + 256 * j) = v[r][j];
            float g[RB][4];
#pragma unroll
            for (int r = 0; r < RB; ++r) { g[r][0] = 0.f; g[r][1] = 0.f; g[r][2] = 0.f; g[r][3] = 0.f; }
#pragma unroll
            for (int i2_ = 0; i2_ < 16; ++i2_) { const int kx = i2_ * 64 + lane; const f32x4 w = *(const GAS f32x4*)(wrg + (size_t)kx * 4);
#pragma unroll
                for (int r = 0; r < RB; ++r) { const float xv = xs[r * 1024 + kx]; g[r][0] += xv * w.x; g[r][1] += xv * w.y; g[r][2] += xv * w.z; g[r][3] += xv * w.w; } }
#pragma unroll
            for (int o = 1; o < 64; o <<= 1) {
#pragma unroll
                for (int r = 0; r < RB; ++r) { g[r][0] += __shfl_xor(g[r][0], o); g[r][1] += __shfl_xor(g[r][1], o); g[r][2] += __shfl_xor(g[r][2], o); g[r][3] += __shfl_xor(g[r][3], o); } }
            int gs[RB]; float gate_g[RB]; float a[RB][4];
#pragma unroll
            for (int r = 0; r < RB; ++r) { const float g0 = g[r][0] + brg[0], g1 = g[r][1] + brg[1], g2 = g[r][2] + brg[2], g3 = g[r][3] + brg[3];
                int gsel = 0; float gm = g0;
                if (g1 > gm) { gm = g1; gsel = 1; } if (g2 > gm) { gm = g2; gsel = 2; } if (g3 > gm) { gm = g3; gsel = 3; }
                gs[r] = __builtin_amdgcn_readfirstlane(gsel);
                gate_g[r] = 1.f / (__expf(g0 - gm) + __expf(g1 - gm) + __expf(g2 - gm) + __expf(g3 - gm));
                a[r][0] = 0.f; a[r][1] = 0.f; a[r][2] = 0.f; a[r][3] = 0.f; }
#pragma unroll 8
            for (int i2_ = 0; i2_ < 32; ++i2_) { const int idx = i2_ * 64 + lane;
#pragma unroll
                for (int r = 0; r < RB; ++r) { const f32x4 w = *(const GAS f32x4*)(wre + (size_t)gs[r] * DM * 8 + (size_t)idx * 4); const float xv = xs[r * 1024 + (idx >> 1)];
                    a[r][0] += xv * w.x; a[r][1] += xv * w.y; a[r][2] += xv * w.z; a[r][3] += xv * w.w; } }
#pragma unroll
            for (int o = 2; o < 64; o <<= 1) {
#pragma unroll
                for (int r = 0; r < RB; ++r) { a[r][0] += __shfl_xor(a[r][0], o); a[r][1] += __shfl_xor(a[r][1], o); a[r][2] += __shfl_xor(a[r][2], o); a[r][3] += __shfl_xor(a[r][3], o); } }
#pragma unroll
            for (int r = 0; r < RB; ++r) { const int row = row0 + r * NGW;
                const float t0 = __shfl_xor(a[r][0], 1), t1 = __shfl_xor(a[r][1], 1), t2 = __shfl_xor(a[r][2], 1), t3 = __shfl_xor(a[r][3], 1);
                const bool odd = lane & 1; const float* be = bre + gs[r] * 8;
                const float e0 = (odd ? t0 : a[r][0]) + be[0], e1 = (odd ? t1 : a[r][1]) + be[1], e2 = (odd ? t2 : a[r][2]) + be[2], e3 = (odd ? t3 : a[r][3]) + be[3];
                const float e4 = (odd ? a[r][0] : t0) + be[4], e5 = (odd ? a[r][1] : t1) + be[5], e6 = (odd ? a[r][2] : t2) + be[6], e7 = (odd ? a[r][3] : t3) + be[7];
                int i1 = 0; float v1 = e0;
                if (e1 > v1) { v1 = e1; i1 = 1; } if (e2 > v1) { v1 = e2; i1 = 2; } if (e3 > v1) { v1 = e3; i1 = 3; }
                if (e4 > v1) { v1 = e4; i1 = 4; } if (e5 > v1) { v1 = e5; i1 = 5; } if (e6 > v1) { v1 = e6; i1 = 6; } if (e7 > v1) { v1 = e7; i1 = 7; }
                int i2 = -1; float v2 = -3.0e38f;
                if (i1 != 0 && e0 > v2) { v2 = e0; i2 = 0; } if (i1 != 1 && e1 > v2) { v2 = e1; i2 = 1; } if (i1 != 2 && e2 > v2) { v2 = e2; i2 = 2; } if (i1 != 3 && e3 > v2) { v2 = e3; i2 = 3; }
                if (i1 != 4 && e4 > v2) { v2 = e4; i2 = 4; } if (i1 != 5 && e5 > v2) { v2 = e5; i2 = 5; } if (i1 != 6 && e6 > v2) { v2 = e6; i2 = 6; } if (i1 != 7 && e7 > v2) { v2 = e7; i2 = 7; }
                const float ex = __expf(v2 - v1);
                if (row < NTOK) {
                    if (lane == 0) { gate[2 * row] = gate_g[r] / (1.f + ex); gate[2 * row + 1] = gate_g[r] * ex / (1.f + ex); }
                    if (lane == 2 * k) { myE = gs[r] * 8 + i1; mySlot = 2 * row; }
                    if (lane == 2 * k + 1) { myE = gs[r] * 8 + i2; mySlot = 2 * row + 1; }
                    ++k; } }
        }
    }
    if constexpr (ROUTER) {
        LAS unsigned* wcnt = (LAS unsigned*)(F.lds + TAB_OFF + 512); LAS unsigned* wbase = wcnt + NEXP;
        if (F.tid < NEXP) wcnt[F.tid] = 0u;
        LDS_WAIT(); __syncthreads();
        unsigned lp = 0u; const bool has = lane < 2 * k;
        if (has) lp = atomicAdd((unsigned*)(wcnt + myE), 1u);
        LDS_WAIT(); __syncthreads();
        if (F.tid < NEXP) { const unsigned n = wcnt[F.tid]; wbase[F.tid] = n ? atomicAdd(cnt + F.tid * CNT_STRIDE, n) : 0u; }
        LDS_WAIT(); __syncthreads();
        if (has) list[(size_t)myE * LIST_CAP + wbase[myE] + lp] = mySlot;
    }
}
__device__ __forceinline__ void emix_phase(Frame& F, const bf16* H, bf16* CAT, const bf16* WSB, const float* lng, const float* lnb, const float* bsp) {
    frame_refresh(F);
    const int lane = F.lane, w = F.wave, fr = lane & 15, fq = lane >> 4;
    LAS unsigned char* BtL = F.lds;
    for (int u = blockIdx.x; u < 1024; u += F.G) {
        if (u < 512) {
            const int chunk = u >> 2, h = u & 3, tb = chunk * CHUNK;
            const int hl = lane - h * 16;
            float gch[8], bch[8];
            if (hl >= 0 && hl < 16) {
#pragma unroll
                for (int j = 0; j < 8; ++j) { gch[j] = lng[h * 128 + hl * 8 + j]; bch[j] = lnb[h * 128 + hl * 8 + j]; } }
            for (int rr = 0; rr < 16; ++rr) { const int r = w * 16 + rr;
                const v4u raw = *(const GAS v4u*)(H + (size_t)(tb + r) * DIN_E + 1024 + lane * 8);
                float x[8] = {bflo(raw.x), bfhi(raw.x), bflo(raw.y), bfhi(raw.y), bflo(raw.z), bfhi(raw.z), bflo(raw.w), bfhi(raw.w)};
                float s = 0.f;
#pragma unroll
                for (int j = 0; j < 8; ++j) s += x[j];
                const float mean = wsum(s) * (1.f / 512.f); float q = 0.f;
#pragma unroll
                for (int j = 0; j < 8; ++j) { x[j] -= mean; q += x[j] * x[j]; }
                const float rstd = 1.f / sqrtf(wsum(q) * (1.f / 512.f) + LN_EPS);
                if (hl >= 0 && hl < 16) {
#pragma unroll
                    for (int j = 0; j < 8; ++j) *(LAS bf16*)(BtL + (hl * 8 + j) * 272 + r * 2) = (bf16)f2bf(x[j] * rstd * gch[j] + bch[j]); }
            }
            LDS_WAIT(); __syncthreads();
            f32x4 acc[8];
#pragma unroll
            for (int nb = 0; nb < 8; ++nb) acc[nb] = (f32x4){0.f, 0.f, 0.f, 0.f};
            const bf16* wsrow = WSB + ((size_t)h * CHUNK + 16 * w + fr) * CHUNK;
#pragma unroll
            for (int s = 0; s < 4; ++s) { if (32 * s <= 16 * w + 15) {
                const bf16x8v af = *(const GAS bf16x8v*)(wsrow + 32 * s + 8 * fq);
#pragma unroll
                for (int nb = 0; nb < 8; ++nb) { const bf16x8v bfr = *(const LAS bf16x8v*)(BtL + (16 * nb + fr) * 272 + (32 * s + 8 * fq) * 2);
                    acc[nb] = __builtin_amdgcn_mfma_f32_16x16x32_bf16(bfr, af, acc[nb], 0, 0, 0); } } }
            const int t = tb + 16 * w + fr; const float bias = bsp[h * CHUNK + 16 * w + fr];
#pragma unroll
            for (int nb = 0; nb < 8; ++nb) { const int c = h * 128 + 16 * nb + 4 * fq;
                const v2u uv = *(const GAS v2u*)(H + (size_t)t * DIN_E + 512 + c);
                v2u o; o.x = pk2(bflo(uv.x) * (acc[nb][0] + bias), bfhi(uv.x) * (acc[nb][1] + bias)); o.y = pk2(bflo(uv.y) * (acc[nb][2] + bias), bfhi(uv.y) * (acc[nb][3] + bias));
                *(GAS v2u*)(CAT + (size_t)t * DM + 512 + c) = o; }
            __syncthreads();
        } else {
            const int uu = u - 512, chunk = uu >> 2, g = uu & 3, win = 2 << g, tb = chunk * CHUNK + 16 * w, s0 = tb & (SEQ - 1);
            const bf16* col = H + g * 128 + 2 * lane;
            float sx = 0.f, sy = 0.f;
            for (int j = 1; j < win; ++j) { if (s0 - j >= 0) { const unsigned a = *(const GAS unsigned*)(col + (size_t)(tb - j) * DIN_E); sx += bflo(a); sy += bfhi(a); } }
            for (int rr = 0; rr < 16; ++rr) { const int t = tb + rr, s = s0 + rr;
                const unsigned a = *(const GAS unsigned*)(col + (size_t)t * DIN_E); const float ax = bflo(a), ay = bfhi(a);
                sx += ax; sy += ay;
                const float inv = 1.f / (float)(s + 1 < win ? s + 1 : win);
                *(GAS unsigned*)(CAT + (size_t)t * DM + g * 128 + 2 * lane) = pk2(sx * inv - ax, sy * inv - ay);
                if (s - win + 1 >= 0) { const unsigned o = *(const GAS unsigned*)(col + (size_t)(t - win + 1) * DIN_E); sx -= bflo(o); sy -= bfhi(o); } }
        }
    }
}
__device__ __forceinline__ void conv_phase(Frame& F, const bf16* ZC, const bf16* BG, bf16* CAT, const float* cw, const float* cb) {
    frame_refresh(F);
    const size_t gtid = (size_t)F.vcu * (NWAVES * 64) + F.tid, nthr = (size_t)F.G * NWAVES * 64;
    for (size_t it = gtid; it < (size_t)NTOK * 128; it += nthr) { const int t = (int)(it >> 7), c8 = (int)(it & 127) * 8, s = t & (SEQ - 1);
        const size_t o = (size_t)t * DM + c8;
        const v4u z0 = *(const GAS v4u*)(ZC + o), bg = *(const GAS v4u*)(BG + o);
        v4u z1 = {0u, 0u, 0u, 0u}, z2 = {0u, 0u, 0u, 0u};
        if (s >= 1) z1 = *(const GAS v4u*)(ZC + o - DM);
        if (s >= 2) z2 = *(const GAS v4u*)(ZC + o - 2 * DM);
        float wv[24], bb[8];
#pragma unroll
        for (int j = 0; j < 6; ++j) { const f32x4 q = *(const GAS f32x4*)(cw + (size_t)c8 * 3 + 4 * j); wv[4 * j] = q.x; wv[4 * j + 1] = q.y; wv[4 * j + 2] = q.z; wv[4 * j + 3] = q.w; }
#pragma unroll
        for (int j = 0; j < 2; ++j) { const f32x4 q = *(const GAS f32x4*)(cb + c8 + 4 * j); bb[4 * j] = q.x; bb[4 * j + 1] = q.y; bb[4 * j + 2] = q.z; bb[4 * j + 3] = q.w; }
        const unsigned z0w[4] = {z0.x, z0.y, z0.z, z0.w}, z1w[4] = {z1.x, z1.y, z1.z, z1.w}, z2w[4] = {z2.x, z2.y, z2.z, z2.w}, bgw[4] = {bg.x, bg.y, bg.z, bg.w};
        unsigned ow[4];
#pragma unroll
        for (int p = 0; p < 4; ++p) {
            const float c0 = bb[2 * p] + bflo(z2w[p]) * wv[6 * p] + bflo(z1w[p]) * wv[6 * p + 1] + bflo(z0w[p]) * wv[6 * p + 2];
            const float c1 = bb[2 * p + 1] + bfhi(z2w[p]) * wv[6 * p + 3] + bfhi(z1w[p]) * wv[6 * p + 4] + bfhi(z0w[p]) * wv[6 * p + 5];
            ow[p] = pk2(bflo(bgw[p]) * c0, bfhi(bgw[p]) * c1); }
        v4u ov; ov.x = ow[0]; ov.y = ow[1]; ov.z = ow[2]; ov.w = ow[3];
        *(GAS v4u*)(CAT + o) = ov; }
}

__global__ void __launch_bounds__(NWAVES * 64, 2) mega(Args args) {
    extern __shared__ __attribute__((aligned(16))) unsigned char lds_raw[];
    Frame F;
    F.lds = (LAS unsigned char*)lds_raw;
    F.tid = threadIdx.x; F.lane = F.tid & 63; F.wave = __builtin_amdgcn_readfirstlane(F.tid >> 6);
    F.G = gridDim.x; { const int bx = blockIdx.x; F.vcu = (F.G % 8 == 0) ? (bx % 8) * (F.G / 8) + bx / 8 : bx; }
    F.ws = args.ws;
    unsigned char* ws = args.ws;
    unsigned* ctl = (unsigned*)(ws + WS_CTL);
    for (int u = F.tid; u < (LDS_BYTES - LDSCTL_OFF) / 4; u += NWAVES * 64) ((LAS unsigned*)(F.lds + LDSCTL_OFF))[u] = 0u;
    __syncthreads();
    const int lo = args.ph_lo, hi = args.ph_hi;
    XcdBarrier bar; bar.bar = ctl + CW_BAR; bar.x = 0; bar.st = nullptr;
    if (hi - lo > 1) bar = xcd_barrier_post(ctl + CW_BAR, (volatile LAS unsigned*)(F.lds + MISC_OFF) + 8);
#ifndef PHMASK
#define PHMASK 0x7fff
#endif
#define PHEN(k) ((PHMASK >> ((k) < NPRE ? 12 + (k) : ((k) - NPRE) % NPL)) & 1)
#define RUN(k) (PHEN(k) && lo <= (k) && (k) < hi)
#define SEAM(k) do { if ((k) + 1 < hi) xcd_barrier(bar); } while (0)
#ifndef DUPMASK
#define DUPMASK 0
#endif
#define NREP(p) (((DUPMASK >> (p)) & 1) ? 2 : 1)
#define REPEAT(p, ...) do { _Pragma("unroll") for (int rep_ = 0; rep_ < NREP(p); ++rep_) { __VA_ARGS__ if (rep_ + 1 < NREP(p)) xcd_barrier(bar); } } while (0)
    float* X = (float*)(ws + WS_X); bf16* XB = (bf16*)(ws + WS_XB); float* Y = (float*)(ws + WS_Y); bf16* CAT = (bf16*)(ws + WS_CAT);
    bf16* KVALL = (bf16*)(ws + WS_KV); bf16* MEMB = (bf16*)(ws + WS_MEMB);
    int* LIST = (int*)(ws + WS_LIST); float* GATE = (float*)(ws + WS_GATE);
    unsigned char* SCR = ws + WS_SCR;
    LAS unsigned char* ring = F.lds;
    const int cblk = (int)blockIdx.x;

    if (RUN(0)) { REPEAT(12, prep_phase(F, args);); SEAM(0); }
    if (RUN(1)) { REPEAT(13,
        pg8::Gemm g{MEMB, (const bf16*)(ws + WS_WK), DM, DM, DM}; pg8::DenseOrder S; S.init(NMEM, 2 * DEPTH * DM, F.G, cblk, DM, DM);
        pg8::EpiBf16 E{KVALL, 2 * DEPTH * DM, 1 << 30}; pg8::gemm_phase<pg8::EpiBf16, pg8::DenseOrder, false>(ring, g, S, E);
        ); SEAM(1);
    }
    if (RUN(2)) { REPEAT(14,
        { pg8::Gemm g{KVALL, (const bf16*)(ws + WS_WQ), 2 * DEPTH * DM, DM, XHD}; FoldOrder S{F.G, cblk, 0};
          pg8::EpiBf16 E{(bf16*)(ws + WS_MT), DM, 1 << 30}; pg8::gemm_phase<pg8::EpiBf16, FoldOrder, false>(ring, g, S, E); }
        { pg8::Gemm g{(const bf16*)(ws + WS_WO), KVALL, DM, 2 * DEPTH * DM, XHD}; FoldOrder S{F.G, cblk, 1};
          pg8::EpiBf16 E{(bf16*)(ws + WS_VW), DM, 1 << 30}; pg8::gemm_phase<pg8::EpiBf16, FoldOrder, false>(ring, g, S, E); }
        ); SEAM(2);
    }
    for (int l = 0; l < DEPTH; ++l) {
        const int base = NPRE + l * NPL, i = l >> 1;
        if (base + NPL <= lo || base >= hi) continue;
        const float* ln_g = args.in[18] + (size_t)l * 3 * DM; const float* ln_b = args.in[19] + (size_t)l * 3 * DM;
        if (RUN(base + 0)) { REPEAT(0,
            if ((l & 1) == 0) { pg8::Gemm g{XB, (const bf16*)(ws + WS_W_EIN) + (size_t)i * DIN_E * DM, DM, DM, DM}; pg8::DenseOrder S; S.init(NTOK, DIN_E, F.G, cblk, DM, DM);
                pg8::EpiBf16 E{(bf16*)SCR, DIN_E, 2}; pg8::gemm_phase<pg8::EpiBf16, pg8::DenseOrder, true>(ring, g, S, E); }
            else { pg8::Gemm g{XB, (const bf16*)(ws + WS_W_OIN) + (size_t)i * DIN_O * DM, DM, DM, DM}; pg8::DenseOrder S; S.init(NTOK, DIN_O, F.G, cblk, DM, DM);
                pg8::EpiPair<0> E{(bf16*)SCR, (bf16*)(SCR + 32 * MiB), DM, 8, DM}; pg8::gemm_phase<pg8::EpiPair<0>, pg8::DenseOrder, true>(ring, g, S, E); }
            ); SEAM(base + 0);
        }
        if (RUN(base + 1)) { REPEAT(1,
            if ((l & 1) == 0) emix_phase(F, (const bf16*)SCR, CAT, (const bf16*)(ws + WS_WSB) + (size_t)i * 4 * CHUNK * CHUNK, args.in[5] + (size_t)i * 512, args.in[6] + (size_t)i * 512, args.in[8] + (size_t)i * 4 * CHUNK);
            else conv_phase(F, (const bf16*)SCR, (const bf16*)(SCR + 32 * MiB), CAT, args.in[11] + (size_t)i * DM * 3, args.in[12] + (size_t)i * DM);
            ); SEAM(base + 1);
        }
        if (RUN(base + 2)) { REPEAT(2,
            const bf16* W = (l & 1) ? (const bf16*)(ws + WS_W_OOUT) + (size_t)i * DM * DM : (const bf16*)(ws + WS_W_EOUT) + (size_t)i * DM * DM;
            pg8::Gemm g{CAT, W, DM, DM, DM}; pg8::DenseOrder S; S.init(NTOK, DM, F.G, cblk, DM, DM);
            pg8::EpiResid E{l == 0 ? args.in[0] : X, Y, DM, ALPHA}; pg8::gemm_phase<pg8::EpiResid, pg8::DenseOrder, false>(ring, g, S, E);
            ); SEAM(base + 2);
        }
        if (RUN(base + 3)) { REPEAT(3, ln_phase<0, false, 4>(F, Y, nullptr, ln_g, ln_b, X, XB, nullptr, nullptr, nullptr, nullptr, nullptr, nullptr, nullptr, nullptr); ); SEAM(base + 3); }
        if (RUN(base + 4)) { REPEAT(4,
            pg8::Gemm g{XB, (const bf16*)(ws + WS_MT), DM, DM, DM}; AttnOrder S{F.G, cblk, l};
            pg8::EpiSoftmax E{(bf16*)SCR, DM, 0.0625f * 1.4426950408889634f}; pg8::gemm_phase<pg8::EpiSoftmax, AttnOrder, false>(ring, g, S, E);
            ); SEAM(base + 4);
        }
        if (RUN(base + 5)) { REPEAT(5,
            pg8::Gemm g{(const bf16*)SCR, (const bf16*)(ws + WS_VW), DM, DM, DM}; AttnOrder S{F.G, cblk, l};
            pg8::EpiResid E{X, Y, DM, ALPHA}; pg8::gemm_phase<pg8::EpiResid, AttnOrder, false>(ring, g, S, E);
            ); SEAM(base + 5);
        }
        unsigned* cnt = ctl + CW_CNT + l * NEXP * CNT_STRIDE;
        if (RUN(base + 6)) {
#if (DUPMASK >> 6) & 1
            ln_phase<0, true, 2>(F, Y, nullptr, ln_g + DM, ln_b + DM, X, XB, nullptr, args.in[20] + (size_t)l * DM * 4, args.in[21] + (size_t)l * 4, args.in[22] + (size_t)l * 4 * DM * 8, args.in[23] + (size_t)l * 32, cnt, LIST, GATE);
            xcd_barrier(bar);
            if (blockIdx.x == 0 && F.tid < NEXP) __hip_atomic_store(cnt + F.tid * CNT_STRIDE, 0u, __ATOMIC_RELAXED, __HIP_MEMORY_SCOPE_AGENT);
            xcd_barrier(bar);
#endif
            ln_phase<0, true, 2>(F, Y, nullptr, ln_g + DM, ln_b + DM, X, XB, nullptr, args.in[20] + (size_t)l * DM * 4, args.in[21] + (size_t)l * 4, args.in[22] + (size_t)l * 4 * DM * 8, args.in[23] + (size_t)l * 32, cnt, LIST, GATE);
            SEAM(base + 6);
        }
        if (RUN(base + 7)) { REPEAT(7,
            moe_tables(F, cnt);
            const LAS int* tab = (const LAS int*)(F.lds + TAB_OFF);
            pg8::Gemm g{XB, (const bf16*)(ws + WS_W13) + (size_t)l * NEXP * DM * DM, DM, DM, DM};
            MoeOrder<true> S{F.G, cblk, 4, tab, tab + 40, LIST, (size_t)DM * DM * 2, DM};
            pg8::EpiMoe1 E{(bf16*)SCR, tab}; pg8::gemm_phase<pg8::EpiMoe1, MoeOrder<true>, true>(ring, g, S, E);
            ); SEAM(base + 7);
        }
        if (RUN(base + 8)) { REPEAT(8,
            moe_tables(F, cnt);
            const LAS int* tab = (const LAS int*)(F.lds + TAB_OFF);
            pg8::Gemm g{(const bf16*)SCR, (const bf16*)(ws + WS_W2) + (size_t)l * NEXP * DM * DEXP, DEXP, DEXP, DEXP};
            MoeOrder<false> S{F.G, cblk, 4, tab, tab + 40, LIST, (size_t)DM * DEXP * 2, DEXP};
            pg8::EpiMoe2 E{(bf16*)(SCR + 96 * MiB), LIST, GATE, LIST_CAP}; pg8::gemm_phase<pg8::EpiMoe2, MoeOrder<false>, true>(ring, g, S, E);
            ); SEAM(base + 8);
        }
        if (RUN(base + 9)) {
            ln_phase<1, false, 4>(F, nullptr, (const bf16*)(SCR + 96 * MiB), ln_g + 2 * DM, ln_b + 2 * DM, X, XB, l == DEPTH - 1 ? args.out : nullptr, nullptr, nullptr, nullptr, nullptr, nullptr, nullptr, nullptr);
            SEAM(base + 9);
        }
    }
#undef RUN
#undef SEAM
}

#ifndef FAST_MASK
#define FAST_MASK 0xff
#endif
template <class P> static void ngemm(P p, int N, int Mmax, int Z, hipStream_t s) { static_assert(sizeof(P) % 8 == 0, "no tail padding"); hipLaunchKernelGGL(k_ngemm<P>, dim3(N / 128, (Mmax + 127) / 128, Z), dim3(256), 0, s, p); }

extern "C" void kernel_launch(void* const* d_in, const int* in_sizes, int n_in, void* d_out, int out_size, void* d_ws, size_t ws_size, hipStream_t stream) {
    static int grid = 0;
    if (grid == 0) {
        if (n_in != 27 || out_size != NTOK * DM || ws_size < WS_END2) { fprintf(stderr, "kernel_launch: unexpected shapes (n_in %d out %d ws %zu need %zu)\n", n_in, out_size, ws_size, (size_t)WS_END2); grid = -1; return; }
        int dev = 0, cus = 0, per_cu = 0;
        if (hipGetDevice(&dev) != hipSuccess || hipDeviceGetAttribute(&cus, hipDeviceAttributeMultiprocessorCount, dev) != hipSuccess) { grid = -1; return; }
        if (hipFuncSetAttribute((const void*)mega, hipFuncAttributeMaxDynamicSharedMemorySize, LDS_BYTES) != hipSuccess) { fprintf(stderr, "kernel_launch: hipFuncSetAttribute failed\n"); grid = -1; return; }
        if (hipOccupancyMaxActiveBlocksPerMultiprocessor(&per_cu, (const void*)mega, NWAVES * 64, LDS_BYTES) != hipSuccess || per_cu < 1) fprintf(stderr, "kernel_launch: occupancy query reports %d\n", per_cu);
        (void)hipGetLastError();
        grid = cus;
        if (grid != 256) fprintf(stderr, "kernel_launch: %d CUs (built for 256)\n", grid);
    }
    if (grid < 0) return;
    const float* in_x = (const float*)d_in[0]; const float* in_mem = (const float*)d_in[1];
    const float* w_in_even = (const float*)d_in[2]; const float* w_pool = (const float*)d_in[3]; const float* pool_scale = (const float*)d_in[4];
    const float* ln_v_g = (const float*)d_in[5]; const float* ln_v_b = (const float*)d_in[6]; const float* w_spatial = (const float*)d_in[7]; const float* b_spatial = (const float*)d_in[8];
    const float* w_out_even = (const float*)d_in[9]; const float* w_in_odd = (const float*)d_in[10]; const float* conv_w = (const float*)d_in[11]; const float* conv_b = (const float*)d_in[12];
    const float* w_out_odd = (const float*)d_in[13]; const float* wq = (const float*)d_in[14]; const float* wk = (const float*)d_in[15]; const float* wv = (const float*)d_in[16]; const float* wo = (const float*)d_in[17];
    const float* ln_g = (const float*)d_in[18]; const float* ln_b = (const float*)d_in[19]; const float* wr_group = (const float*)d_in[20]; const float* br_group = (const float*)d_in[21];
    const float* wr_expert = (const float*)d_in[22]; const float* br_expert = (const float*)d_in[23]; const float* w1 = (const float*)d_in[24]; const float* w3 = (const float*)d_in[25]; const float* w2 = (const float*)d_in[26];
    char* ws = (char*)d_ws;
    unsigned* ctl = (unsigned*)(ws + WS_CTL);
    float* X = (float*)(ws + WS_X); bf16* XB = (bf16*)(ws + WS_XB); float* Y = (float*)(ws + WS_Y); bf16* CAT = (bf16*)(ws + WS_CAT);
    bf16* MEMB = (bf16*)(ws + WS_MEMB);
    int* LIST = (int*)(ws + WS_LIST); float* GATE = (float*)(ws + WS_GATE);
    char* SCR = ws + WS_SCR;
    (void)hipMemsetAsync(ctl, 0, CTL_BYTES, stream);
    Args a{};
    for (int i = 0; i < 27; ++i) a.in[i] = (const float*)d_in[i];
    a.out = (float*)d_out; a.ws = (unsigned char*)d_ws;
    auto phase = [&](int lo, int hi) { a.ph_lo = lo; a.ph_hi = hi; hipLaunchKernelGGL(mega, dim3(grid), dim3(NWAVES * 64), LDS_BYTES, stream, a); };
    constexpr unsigned FM = FAST_MASK;
    if (FM == 0xff) { phase(0, NPHASE); return; }
    bf16* KVB = (bf16*)(ws + WS_KV); const int LDKV = 2 * DEPTH * DM;
    hipLaunchKernelGGL(k_cvt, dim3(2048), dim3(256), 0, stream, in_x, X, XB, (size_t)NTOK * DM);
    if (FM & 1) { phase(0, 1); phase(1, 2); phase(2, 3); }
    else {
        hipLaunchKernelGGL(k_cvt, dim3(512), dim3(256), 0, stream, in_mem, (float*)nullptr, MEMB, (size_t)NMEM * DM);
        for (int l = 0; l < DEPTH; ++l) {
            ngemm(PBf16ToBf16{MEMB, wk + (size_t)l * DM * DM, KVB + (size_t)l * DM, DM, DM, DM, NMEM, LDKV, 0}, DM, NMEM, 1, stream);
            ngemm(PBf16ToBf16{MEMB, wv + (size_t)l * DM * DM, KVB + (size_t)(DEPTH + l) * DM, DM, DM, DM, NMEM, LDKV, 0}, DM, NMEM, 1, stream);
        }
    }
    for (int l = 0; l < DEPTH; ++l) {
        const int i = l / 2, base = NPRE + l * NPL;
        if (FM & 2) { phase(base + 0, base + 1); phase(base + 1, base + 2); }
        else if (l % 2 == 0) {
            float* Hf = (float*)SCR; float* D = (float*)(SCR + 96 * MiB);
            ngemm(PBf16ToF32{XB, w_in_even + (size_t)i * DM * DIN_E, Hf, DM, DIN_E, DM, NTOK, DIN_E, 0}, DIN_E, NTOK, 1, stream);
            hipLaunchKernelGGL(k_even_pool, dim3(NTOK * 512 / 256), dim3(256), 0, stream, Hf, D);
            ngemm(PPool{D, w_pool + (size_t)i * 4 * 128 * 128, pool_scale + (size_t)i * 512, CAT}, 128, NTOK, 4, stream);
            hipLaunchKernelGGL(k_even_gelu_ln, dim3(NTOK / 4), dim3(256), 0, stream, Hf, ln_v_g + (size_t)i * 512, ln_v_b + (size_t)i * 512);
            hipLaunchKernelGGL(k_even_gate, dim3(NTOK * 512 / 256), dim3(256), 0, stream, Hf, w_spatial + (size_t)i * 4 * 128 * 128, b_spatial + (size_t)i * 4 * 128, CAT);
        } else {
            float* ZC = (float*)SCR; float* BG = (float*)(SCR + 64 * MiB);
            const float* W = w_in_odd + (size_t)i * DM * DIN_O;
            ngemm(PBf16ToF32{XB, W + DM, ZC, DM, DIN_O, DM, NTOK, DM, 0}, DM, NTOK, 1, stream);
            ngemm(PBf16MulF32{XB, W + 2 * DM, ZC, DM, DIN_O, DM, NTOK, DM, 0}, DM, NTOK, 1, stream);
            ngemm(PBf16ToF32{XB, W, BG, DM, DIN_O, DM, NTOK, DM, 0}, DM, NTOK, 1, stream);
            hipLaunchKernelGGL(k_odd_conv, dim3(NTOK * DM / 256), dim3(256), 0, stream, ZC, BG, conv_w + (size_t)i * DM * 3, conv_b + (size_t)i * DM, CAT);
        }
        if (FM & 4) phase(base + 2, base + 3);
        else ngemm(PResid{CAT, (l % 2 ? w_out_odd : w_out_even) + (size_t)i * DM * DM, l == 0 ? in_x : X, Y, DM, DM, DM, NTOK}, DM, NTOK, 1, stream);
        if (FM & 8) phase(base + 3, base + 4);
        else hipLaunchKernelGGL(k_ln, dim3(NTOK / 4), dim3(256), 0, stream, Y, (const float*)nullptr, (const bf16*)nullptr, ln_g + (size_t)(l * 3 + 0) * DM, ln_b + (size_t)(l * 3 + 0) * DM, X, XB, (float*)nullptr);
        if (FM & 16) { phase(base + 4, base + 5); phase(base + 5, base + 6); }
        else {
            bf16* Q = (bf16*)SCR; bf16* O = (bf16*)(SCR + 32 * MiB);
            ngemm(PBf16ToBf16{XB, wq + (size_t)l * DM * DM, Q, DM, DM, DM, NTOK, DM, 0}, DM, NTOK, 1, stream);
            hipLaunchKernelGGL(k_attn, dim3(NTOK, NXH), dim3(256), 0, stream, Q, KVB + (size_t)l * DM, KVB + (size_t)(DEPTH + l) * DM, LDKV, O);
            ngemm(PResid{O, wo + (size_t)l * DM * DM, X, Y, DM, DM, DM, NTOK}, DM, NTOK, 1, stream);
        }
        unsigned* cnt = ctl + CW_CNT + l * NEXP * CNT_STRIDE; unsigned* off = ctl + CW_OFF + l * (NEXP + 1);
        if (FM & 32) phase(base + 6, base + 7);
        else {
            hipLaunchKernelGGL(k_ln, dim3(NTOK / 4), dim3(256), 0, stream, Y, (const float*)nullptr, (const bf16*)nullptr, ln_g + (size_t)(l * 3 + 1) * DM, ln_b + (size_t)(l * 3 + 1) * DM, X, XB, (float*)nullptr);
            hipLaunchKernelGGL(k_router, dim3(NTOK / 4), dim3(256), 0, stream, X, wr_group + (size_t)l * DM * 4, br_group + (size_t)l * 4, wr_expert + (size_t)l * 4 * DM * 8, br_expert + (size_t)l * 32, cnt, LIST, GATE);
        }
        bf16* OUT2 = (bf16*)(SCR + 96 * MiB);
        if (FM & 64) { phase(base + 7, base + 8); phase(base + 8, base + 9); }
        else {
            float* HID = (float*)SCR;
            hipLaunchKernelGGL(k_offsets, dim3(1), dim3(64), 0, stream, cnt, off);
            ngemm(PMoe1{XB, LIST, cnt, off, w1 + (size_t)l * NEXP * DM * DEXP, HID, 0, 0}, DEXP, NTOK, NEXP, stream);
            ngemm(PMoe1{XB, LIST, cnt, off, w3 + (size_t)l * NEXP * DM * DEXP, HID, 1, 0}, DEXP, NTOK, NEXP, stream);
            ngemm(PMoe2{HID, LIST, cnt, off, w2 + (size_t)l * NEXP * DEXP * DM, GATE, OUT2}, DM, NTOK, NEXP, stream);
        }
        if (FM & 128) phase(base + 9, base + 10);
        else hipLaunchKernelGGL(k_ln, dim3(NTOK / 4), dim3(256), 0, stream, (const float*)nullptr, X, OUT2, ln_g + (size_t)(l * 3 + 2) * DM, ln_b + (size_t)(l * 3 + 2) * DM, X, XB, (l == DEPTH - 1) ? (float*)d_out : (float*)nullptr);
    }
}
```
